# Optimizing an MI355X kernel written in HIP

```python
import math
import jax, jax.numpy as jnp
from jax import lax
import numpy as np

D_MODEL = 1024
BATCH = 16
SEQ = 2048
DEPTH = 1
DEC_BATCH = 32
DEC_SEQ = 32
PAST_LEN = 4096

CHUNK = 64
QBLK = 128
PE_DIM = 256
DA_HEADS = 4
DA_HD = 64
DA_VD = 2 * DA_HD
RT_HEADS = 4
RT_KD = 128
RT_VD = 128
D_FF = 2816
CONV_W = 3
N_BUCKETS = 32
MAX_DIST = 128
EPS = 1e-6
ROPE_BASE = 10000.0

DA_Q = DA_HEADS * 2 * DA_HD
DA_K = DA_HEADS * 2 * DA_HD
DA_V = DA_HEADS * DA_VD
RT_Q = RT_HEADS * RT_KD
RT_K = RT_HEADS * RT_KD
RT_V = RT_HEADS * RT_VD
RT_G = RT_HEADS * RT_VD
IN_WIDTHS = (DA_Q, DA_K, DA_V, RT_Q, RT_K, RT_V, RT_G, D_MODEL, D_MODEL)
D_IN = DA_Q + DA_K + DA_V + RT_Q + RT_K + RT_V + RT_G + 2 * D_MODEL

kernel_name = "diffattn_retention_parallel_streaming_encoder"


def rmsnorm(x, g):
    xf = x.astype(jnp.float32)
    y = xf * lax.rsqrt(jnp.mean(xf * xf, axis=-1, keepdims=True) + EPS)
    return (y * g.astype(jnp.float32)).astype(x.dtype)


def t5_bucket(rel):
    nb = N_BUCKETS // 2
    ret = jnp.where(rel > 0, nb, 0)
    n = jnp.abs(rel)
    max_exact = nb // 2
    nf = jnp.maximum(n, 1).astype(jnp.float32)
    large = max_exact + (jnp.log(nf / max_exact) / math.log(MAX_DIST / max_exact) * (nb - max_exact)).astype(jnp.int32)
    large = jnp.minimum(large, nb - 1)
    return ret + jnp.where(n < max_exact, n, large)


def diff_attn_block(q1, q2, qpos, k1, k2, v, kpos, rel_bias, lam):
    bias = jnp.transpose(rel_bias[t5_bucket(kpos[None, :] - qpos[:, None])], (2, 0, 1)).astype(jnp.float32)
    mask = (kpos[None, :] // CHUNK) <= (qpos[:, None] // CHUNK)

    def probs(q, k):
        s = jnp.einsum('bqhd,bkhd->bhqk', q, k).astype(jnp.float32) + bias
        s = jnp.where(mask, s, -jnp.inf)
        return jax.nn.softmax(s, axis=-1)

    a = probs(q1, k1) - lam * probs(q2, k2)
    return jnp.einsum('bhqk,bkhe->bqhe', a.astype(v.dtype), v)


def diff_attention(q1, q2, qpos, k1, k2, v, kpos, rel_bias, lam):
    B, T, H, _ = q1.shape
    blk = min(QBLK, T)
    nb = T // blk

    def to_blocks(x):
        return x.reshape((B, nb, blk) + x.shape[2:]).swapaxes(0, 1)

    def one(args):
        bq1, bq2, bqp = args
        return diff_attn_block(bq1, bq2, bqp, k1, k2, v, kpos, rel_bias, lam)

    o = lax.map(one, (to_blocks(q1), to_blocks(q2), qpos.reshape(nb, blk)))
    return o.swapaxes(0, 1).reshape(B, T, H, v.shape[-1])


def rotary(x, pos):
    half = x.shape[-1] // 2
    inv = jnp.power(ROPE_BASE, -jnp.arange(half, dtype=jnp.float32) / half)
    ang = pos.astype(jnp.float32)[:, None] * inv[None, :]
    cos = jnp.cos(ang)[None, :, None, :]
    sin = jnp.sin(ang)[None, :, None, :]
    xf = x.astype(jnp.float32)
    x1, x2 = xf[..., :half], xf[..., half:]
    return jnp.concatenate([x1 * cos - x2 * sin, x1 * sin + x2 * cos], axis=-1).astype(x.dtype)


def retention(q, k, v, s0):
    B, T, H, dk = q.shape
    dv = v.shape[-1]
    c = min(CHUNK, T)
    n = T // c
    f32 = jnp.float32
    log_g = jnp.log1p(-jnp.power(2.0, -5.0 - jnp.arange(H, dtype=f32)))
    idx = jnp.arange(c, dtype=f32)
    diff = idx[:, None] - idx[None, :]
    dec_intra = jnp.where(diff >= 0, jnp.exp(log_g[:, None, None] * jnp.maximum(diff, 0.0)), 0.0)
    dec_q = jnp.exp(log_g[None, :] * (idx + 1.0)[:, None])
    dec_k = jnp.exp(log_g[None, :] * (c - 1.0 - idx)[:, None])
    dec_c = jnp.exp(log_g * c)

    def to_chunks(x):
        return x.astype(f32).reshape((B, n, c) + x.shape[2:]).swapaxes(0, 1)

    def step(S, inp):
        qi, ki, vi = inp
        att = jnp.einsum('bqhd,bkhd->bhqk', qi, ki) * dec_intra
        o = jnp.einsum('bhqk,bkhe->bqhe', att, vi)
        o = o + jnp.einsum('bqhd,bhde->bqhe', qi, S) * dec_q[None, :, :, None]
        S = S * dec_c[None, :, None, None] + jnp.einsum('bkhd,bkhe->bhde', ki * dec_k[None, :, :, None], vi)
        return S, o

    S, o = lax.scan(step, s0.astype(f32), (to_chunks(q), to_chunks(k), to_chunks(v)))
    return o.swapaxes(0, 1).reshape(B, T, H, dv), S.astype(s0.dtype)


def conv_ffn(f, s_conv, w_g, w_u, conv_w, conv_b, w_d):
    T = f.shape[1]
    g = f @ w_g
    u = f @ w_u
    gp = jnp.concatenate([s_conv.astype(g.dtype), g], axis=1)
    gc = conv_b + gp[:, 0:T] * conv_w[0]
    for j in range(1, CONV_W):
        gc = gc + gp[:, j:j + T] * conv_w[j]
    y = (jax.nn.gelu(gc) * u) @ w_d
    return y, gp[:, -(CONV_W - 1):]


def _layer(h, pe, cache_k, cache_v, s_ret, s_conv, rel_bias, lam_init,
           g_mix, w_in, g_q, g_k, lam_q1, lam_k1, lam_q2, lam_k2, g_da, g_rt,
           w_bd, w_br, w_o, g_ffn, w_g, w_u, conv_w, conv_b, w_d, g_pe, w_pe, w_pg):
    B, T, _ = h.shape
    past = 0 if cache_k is None else cache_k.shape[1]
    qpos = past + jnp.arange(T, dtype=jnp.int32)
    kpos = jnp.arange(past + T, dtype=jnp.int32)

    a = rmsnorm(h, g_mix)
    z = a @ w_in
    pts = np.cumsum(IN_WIDTHS)[:-1].tolist()
    qd, kd, vd, qr, kr, vr, gr, gate_d, gate_r = jnp.split(z, pts, axis=-1)

    q = rmsnorm(qd.reshape(B, T, DA_HEADS, 2, DA_HD), g_q) * (DA_HD ** -0.5)
    k = rmsnorm(kd.reshape(B, T, DA_HEADS, 2, DA_HD), g_k)
    v = vd.reshape(B, T, DA_HEADS, DA_VD)
    k_rows = k.reshape(B, T, DA_HEADS, 2 * DA_HD)
    if cache_k is None:
        k_all, v_all = k_rows, v
    else:
        k_all = jnp.concatenate([cache_k.astype(k_rows.dtype), k_rows], axis=1)
        v_all = jnp.concatenate([cache_v.astype(v.dtype), v], axis=1)
    lam = (jnp.exp(jnp.sum(lam_q1.astype(jnp.float32) * lam_k1.astype(jnp.float32)))
           - jnp.exp(jnp.sum(lam_q2.astype(jnp.float32) * lam_k2.astype(jnp.float32))) + lam_init)
    o_d = diff_attention(q[..., 0, :], q[..., 1, :], qpos, k_all[..., :DA_HD], k_all[..., DA_HD:],
                         v_all, kpos, rel_bias, lam)
    o_d = (rmsnorm(o_d, g_da) * (1.0 - lam_init)).reshape(B, T, DA_V)

    qr = rotary(qr.reshape(B, T, RT_HEADS, RT_KD), qpos)
    kr = rotary(kr.reshape(B, T, RT_HEADS, RT_KD), qpos) * (RT_KD ** -0.5)
    vr = vr.reshape(B, T, RT_HEADS, RT_VD)
    s0 = jnp.zeros((B, RT_HEADS, RT_KD, RT_VD), jnp.float32) if s_ret is None else s_ret
    o_r, s_new = retention(qr, kr, vr, s0)
    o_r = rmsnorm(o_r.astype(h.dtype), g_rt).reshape(B, T, RT_V) * jax.nn.silu(gr)

    mix = jax.nn.sigmoid(gate_d) * (o_d @ w_bd) + jax.nn.sigmoid(gate_r) * (o_r @ w_br)
    h = h + mix @ w_o

    sc = jnp.zeros((B, CONV_W - 1, D_FF), h.dtype) if s_conv is None else s_conv
    ffn_out, conv_new = conv_ffn(rmsnorm(h, g_ffn), sc, w_g, w_u, conv_w, conv_b, w_d)
    h = h + ffn_out

    h = h + (pe.astype(h.dtype) @ w_pe) * jax.nn.sigmoid(rmsnorm(h, g_pe) @ w_pg)
    return h, k_rows, v, s_new, conv_new


def setup_inputs(seed: int = 0) -> dict:
    key = jax.random.key(seed)
    ks = jax.random.split(key, 40)

    def nrm(k, shape, scale):
        return jax.random.normal(k, shape, jnp.float32) * scale

    def gain(k, shape):
        return 1.0 + 0.01 * jax.random.normal(k, shape, jnp.float32)

    L = DEPTH
    return {
        "x_prompt": nrm(ks[0], (BATCH, SEQ, D_MODEL), 1.0),
        "x_sample": nrm(ks[1], (DEC_BATCH, DEC_SEQ, D_MODEL), 1.0),
        "p_prompt": nrm(ks[2], (L, BATCH, SEQ, PE_DIM), 1.0),
        "p_sample": nrm(ks[3], (L, DEC_BATCH, DEC_SEQ, PE_DIM), 1.0),
        "cache_k": nrm(ks[4], (L, DEC_BATCH, PAST_LEN, DA_HEADS, 2 * DA_HD), 1.0),
        "cache_v": nrm(ks[5], (L, DEC_BATCH, PAST_LEN, DA_HEADS, DA_VD), 1.0),
        "state_ret": nrm(ks[6], (L, DEC_BATCH, RT_HEADS, RT_KD, RT_VD), 0.3),
        "state_conv": nrm(ks[7], (L, DEC_BATCH, CONV_W - 1, D_FF), 1.0),
        "rel_bias": nrm(ks[8], (N_BUCKETS, DA_HEADS), 0.5),
        "g_mix": gain(ks[9], (L, D_MODEL)),
        "w_in": nrm(ks[10], (L, D_MODEL, D_IN), D_MODEL ** -0.5),
        "g_q": gain(ks[11], (L, DA_HD)),
        "g_k": gain(ks[12], (L, DA_HD)),
        "lam_q1": nrm(ks[13], (L, DA_HD), 0.1),
        "lam_k1": nrm(ks[14], (L, DA_HD), 0.1),
        "lam_q2": nrm(ks[15], (L, DA_HD), 0.1),
        "lam_k2": nrm(ks[16], (L, DA_HD), 0.1),
        "g_da": gain(ks[17], (L, DA_VD)),
        "g_rt": gain(ks[18], (L, RT_VD)),
        "w_bd": nrm(ks[19], (L, DA_V, D_MODEL), DA_V ** -0.5),
        "w_br": nrm(ks[20], (L, RT_V, D_MODEL), RT_V ** -0.5),
        "w_o": nrm(ks[21], (L, D_MODEL, D_MODEL), D_MODEL ** -0.5),
        "g_ffn": gain(ks[22], (L, D_MODEL)),
        "w_g": nrm(ks[23], (L, D_MODEL, D_FF), D_MODEL ** -0.5),
        "w_u": nrm(ks[24], (L, D_MODEL, D_FF), D_MODEL ** -0.5),
        "conv_w": nrm(ks[25], (L, CONV_W, D_FF), CONV_W ** -0.5),
        "conv_b": nrm(ks[26], (L, D_FF), 0.01),
        "w_d": nrm(ks[27], (L, D_FF, D_MODEL), D_FF ** -0.5),
        "g_pe": gain(ks[28], (L, D_MODEL)),
        "w_pe": nrm(ks[29], (L, PE_DIM, D_MODEL), PE_DIM ** -0.5),
        "w_pg": nrm(ks[30], (L, D_MODEL, D_MODEL), D_MODEL ** -0.5),
    }


def reference(x_prompt, x_sample, p_prompt, p_sample, cache_k, cache_v, state_ret, state_conv,
              rel_bias, g_mix, w_in, g_q, g_k, lam_q1, lam_k1, lam_q2, lam_k2, g_da, g_rt,
              w_bd, w_br, w_o, g_ffn, w_g, w_u, conv_w, conv_b, w_d, g_pe, w_pe, w_pg):
    hp, hs = x_prompt, x_sample
    kps, vps, rps, cps = [], [], [], []
    kss, vss, rss, css = [], [], [], []
    for i in range(DEPTH):
        lam_init = 0.8 - 0.6 * math.exp(-0.3 * i)
        w = (g_mix[i], w_in[i], g_q[i], g_k[i], lam_q1[i], lam_k1[i], lam_q2[i], lam_k2[i],
             g_da[i], g_rt[i], w_bd[i], w_br[i], w_o[i], g_ffn[i], w_g[i], w_u[i],
             conv_w[i], conv_b[i], w_d[i], g_pe[i], w_pe[i], w_pg[i])
        hp, kp, vp, rp, cp = _layer(hp, p_prompt[i], None, None, None, None, rel_bias, lam_init, *w)
        hs, ksm, vsm, rsm, csm = _layer(hs, p_sample[i], cache_k[i], cache_v[i], state_ret[i],
                                        state_conv[i], rel_bias, lam_init, *w)
        kps.append(kp); vps.append(vp); rps.append(rp); cps.append(cp)
        kss.append(ksm); vss.append(vsm); rss.append(rsm); css.append(csm)
    k_prompt = jnp.stack(kps)
    v_prompt = jnp.stack(vps)
    ret_prompt = jnp.stack(rps)
    conv_prompt = jnp.stack(cps)
    k_sample = jnp.stack(kss)
    v_sample = jnp.stack(vss)
    ret_sample = jnp.stack(rss)
    conv_sample = jnp.stack(css)
    return (hp, hs, k_prompt, v_prompt, ret_prompt, conv_prompt, k_sample, v_sample, ret_sample, conv_sample)
```

```cpp
#include <hip/hip_runtime.h>
#include <stdint.h>
#include <cstdio>

typedef unsigned short bf16_t;
typedef short bf16x8 __attribute__((ext_vector_type(8)));
typedef float f32x4 __attribute__((ext_vector_type(4)));

constexpr int D = 1024, MP = 32768, MS = 1024, M = MP + MS, TP = 2048, TS = 32, PAST = 4096;
constexpr int DIN = 5632, DFF = 2816, PE = 256;
constexpr float EPS = 1e-6f;
constexpr float LAM_INIT = 0.2f;

__device__ __forceinline__ unsigned short f2bf(float f) { unsigned u = __float_as_uint(f); return (unsigned short)((u + 0x7fffu + ((u >> 16) & 1u)) >> 16); }
__device__ __forceinline__ float bf2f(unsigned short b) { return __uint_as_float(((unsigned)b) << 16); }
__device__ __forceinline__ float sigmoidf_(float x) { return 1.f / (1.f + __expf(-x)); }
__device__ __forceinline__ float gelu_tanh(float x) { const float u = 0.7978845608028654f * (x + 0.044715f * x * x * x); return 0.5f * x * (1.f + tanhf(u)); }
__device__ __forceinline__ void row_info(int m, int& b, int& t, int& pos) {
    if (m < MP) { b = m >> 11; t = m & 2047; pos = t; } else { const int ms = m - MP; b = ms >> 5; t = ms & 31; pos = PAST + t; }
}
__device__ __forceinline__ int t5_bucket(int rel) {
    const int ret = rel > 0 ? 16 : 0; const int n = rel < 0 ? -rel : rel;
    int v;
    if (n < 8) v = n; else if (n < 12) v = 8; else if (n < 16) v = 9; else if (n < 23) v = 10; else if (n < 32) v = 11; else if (n < 46) v = 12; else if (n < 64) v = 13; else if (n < 91) v = 14; else v = 15;
    return ret + v;
}

__global__ void __launch_bounds__(256) k_rmsnorm(const float* __restrict__ xp, const float* __restrict__ xs, const float* __restrict__ g, bf16_t* __restrict__ out) {
    const int row = (blockIdx.x * 256 + threadIdx.x) >> 6, lane = threadIdx.x & 63;
    if (row >= M) return;
    const float* xr = row < MP ? xp + (size_t)row * D : xs + (size_t)(row - MP) * D;
    float4 v[4]; float ss = 0.f;
#pragma unroll
    for (int j = 0; j < 4; ++j) { v[j] = ((const float4*)xr)[lane + 64 * j]; ss += v[j].x * v[j].x + v[j].y * v[j].y + v[j].z * v[j].z + v[j].w * v[j].w; }
#pragma unroll
    for (int o = 1; o < 64; o <<= 1) ss += __shfl_xor(ss, o);
    const float rstd = rsqrtf(ss * (1.f / D) + EPS);
#pragma unroll
    for (int j = 0; j < 4; ++j) { const float4 gv = ((const float4*)g)[lane + 64 * j];
        ushort4 o; o.x = f2bf(v[j].x * rstd * gv.x); o.y = f2bf(v[j].y * rstd * gv.y); o.z = f2bf(v[j].z * rstd * gv.z); o.w = f2bf(v[j].w * rstd * gv.w);
        ((ushort4*)(out + (size_t)row * D))[lane + 64 * j] = o; }
}
__global__ void __launch_bounds__(256) k_cvt_pe(const float* __restrict__ pp, const float* __restrict__ ps, bf16_t* __restrict__ out) {
    const size_t i = (size_t)blockIdx.x * 256 + threadIdx.x;
    if (i >= (size_t)M * PE / 4) return;
    const size_t e = i * 4; const float4 v = e < (size_t)MP * PE ? ((const float4*)pp)[i] : ((const float4*)ps)[i - (size_t)MP * PE / 4];
    ushort4 o; o.x = f2bf(v.x); o.y = f2bf(v.y); o.z = f2bf(v.z); o.w = f2bf(v.w); ((ushort4*)out)[i] = o;
}

struct GemmArgs { const bf16_t* A; const float* W; int lda, N, K, pad; };
template <class Epi>
__global__ void __launch_bounds__(256) k_gemm(GemmArgs ga, Epi epi) {
    const bf16_t* __restrict__ A = ga.A; const float* __restrict__ W = ga.W; const int lda = ga.lda, N = ga.N, K = ga.K;
    __shared__ __attribute__((aligned(16))) bf16_t As[64][40];
    __shared__ __attribute__((aligned(16))) bf16_t Bs[64][40];
    const int tid = threadIdx.x, lane = tid & 63, w = tid >> 6, fr = lane & 15, fq = lane >> 4;
    const int n0 = blockIdx.x * 64, m0 = blockIdx.y * 64;
    f32x4 acc[4];
#pragma unroll
    for (int i = 0; i < 4; ++i) acc[i] = (f32x4){0.f, 0.f, 0.f, 0.f};
    const int ar = tid >> 2, ac = (tid & 3) * 8;
    const int wk = tid >> 3, wn = (tid & 7) * 8;
    for (int k0 = 0; k0 < K; k0 += 32) {
        const uint4 av = *(const uint4*)(A + (size_t)(m0 + ar) * lda + k0 + ac);
        const float4 w0 = *(const float4*)(W + (size_t)(k0 + wk) * N + n0 + wn), w1 = *(const float4*)(W + (size_t)(k0 + wk) * N + n0 + wn + 4);
        __syncthreads();
        *(uint4*)&As[ar][ac] = av;
        Bs[wn + 0][wk] = f2bf(w0.x); Bs[wn + 1][wk] = f2bf(w0.y); Bs[wn + 2][wk] = f2bf(w0.z); Bs[wn + 3][wk] = f2bf(w0.w);
        Bs[wn + 4][wk] = f2bf(w1.x); Bs[wn + 5][wk] = f2bf(w1.y); Bs[wn + 6][wk] = f2bf(w1.z); Bs[wn + 7][wk] = f2bf(w1.w);
        __syncthreads();
        const bf16x8 a = *(const bf16x8*)&As[16 * w + fr][8 * fq];
#pragma unroll
        for (int nt = 0; nt < 4; ++nt) { const bf16x8 b = *(const bf16x8*)&Bs[16 * nt + fr][8 * fq]; acc[nt] = __builtin_amdgcn_mfma_f32_16x16x32_bf16(a, b, acc[nt], 0, 0, 0); }
    }
#pragma unroll
    for (int nt = 0; nt < 4; ++nt)
#pragma unroll
        for (int j = 0; j < 4; ++j) epi(m0 + 16 * w + fq * 4 + j, n0 + 16 * nt + fr, acc[nt][j]);
}
struct EpiBf16 { bf16_t* out; int ld; int pad; __device__ void operator()(int r, int c, float v) const { out[(size_t)r * ld + c] = f2bf(v); } };
struct EpiF32 { float* out; int ld; int pad; __device__ void operator()(int r, int c, float v) const { out[(size_t)r * ld + c] = v; } };
struct EpiGate { const bf16_t* gate; float* out; __device__ void operator()(int r, int c, float v) const { const size_t i = (size_t)r * D + c; out[i] = v * bf2f(gate[i]); } };
struct EpiMix { const float* t1; const bf16_t* gate; bf16_t* out; __device__ void operator()(int r, int c, float v) const { const size_t i = (size_t)r * D + c; out[i] = f2bf(t1[i] + v * bf2f(gate[i])); } };
struct EpiRes { const float* rp; const float* rs; float* out; __device__ void operator()(int r, int c, float v) const {
    const float res = r < MP ? rp[(size_t)r * D + c] : rs[(size_t)(r - MP) * D + c]; out[(size_t)r * D + c] = res + v; } };
struct EpiFinal { float* y; const float* tpe; __device__ void operator()(int r, int c, float v) const { const size_t i = (size_t)r * D + c; y[i] = y[i] + tpe[i] * sigmoidf_(v); } };

struct PostIn { const bf16_t* Z; const float *g_q, *g_k; bf16_t *QD, *KD, *VD, *QR, *KR, *VR, *GRS, *GD, *GT; float *kp, *ks, *vp, *vs; };
__global__ void __launch_bounds__(256) k_post_in(PostIn p) {
    const int m = blockIdx.x, tid = threadIdx.x; int b, t, pos; row_info(m, b, t, pos);
    const bf16_t* z = p.Z + (size_t)m * DIN;
    float* kout = m < MP ? p.kp + (size_t)m * 512 : p.ks + (size_t)(m - MP) * 512;
    float* vout = m < MP ? p.vp + (size_t)m * 512 : p.vs + (size_t)(m - MP) * 512;
    {
        const int c = tid * 2; const float q0 = bf2f(z[c]), q1 = bf2f(z[c + 1]), k0 = bf2f(z[512 + c]), k1 = bf2f(z[512 + c + 1]);
        float sq = q0 * q0 + q1 * q1, sk = k0 * k0 + k1 * k1;
#pragma unroll
        for (int o = 1; o < 32; o <<= 1) { sq += __shfl_xor(sq, o); sk += __shfl_xor(sk, o); }
        const float rq = rsqrtf(sq * (1.f / 64.f) + EPS) * 0.125f, rk = rsqrtf(sk * (1.f / 64.f) + EPS);
        const int d = c & 63;
        p.QD[(size_t)m * 512 + c] = f2bf(q0 * rq * p.g_q[d]); p.QD[(size_t)m * 512 + c + 1] = f2bf(q1 * rq * p.g_q[d + 1]);
        const float kn0 = k0 * rk * p.g_k[d], kn1 = k1 * rk * p.g_k[d + 1];
        p.KD[(size_t)m * 512 + c] = f2bf(kn0); p.KD[(size_t)m * 512 + c + 1] = f2bf(kn1); kout[c] = kn0; kout[c + 1] = kn1;
        const float v0 = bf2f(z[1024 + c]), v1 = bf2f(z[1024 + c + 1]);
        p.VD[(size_t)m * 512 + c] = z[1024 + c]; p.VD[(size_t)m * 512 + c + 1] = z[1024 + c + 1]; vout[c] = v0; vout[c + 1] = v1;
    }
    {
        const int h = tid >> 6, i = tid & 63;
        const float inv = powf(10000.f, -(float)i / 64.f); const float ang = (float)pos * inv; float sn, cs; sincosf(ang, &sn, &cs);
        const float q1 = bf2f(z[1536 + h * 128 + i]), q2 = bf2f(z[1536 + h * 128 + 64 + i]);
        p.QR[(size_t)m * 512 + h * 128 + i] = f2bf(q1 * cs - q2 * sn); p.QR[(size_t)m * 512 + h * 128 + 64 + i] = f2bf(q1 * sn + q2 * cs);
        const float k1 = bf2f(z[2048 + h * 128 + i]), k2 = bf2f(z[2048 + h * 128 + 64 + i]); const float sc = 0.08838834764831845f;
        p.KR[(size_t)m * 512 + h * 128 + i] = f2bf((k1 * cs - k2 * sn) * sc); p.KR[(size_t)m * 512 + h * 128 + 64 + i] = f2bf((k1 * sn + k2 * cs) * sc);
    }
    for (int c = tid; c < 512; c += 256) { p.VR[(size_t)m * 512 + c] = z[2560 + c]; const float g = bf2f(z[3072 + c]); p.GRS[(size_t)m * 512 + c] = f2bf(g * sigmoidf_(g)); }
    for (int c = tid; c < 1024; c += 256) { p.GD[(size_t)m * D + c] = f2bf(sigmoidf_(bf2f(z[3584 + c]))); p.GT[(size_t)m * D + c] = f2bf(sigmoidf_(bf2f(z[4608 + c]))); }
}

struct AttnP { const bf16_t *QD, *KD, *VD; const float *ck, *cv, *rel_bias, *lq1, *lk1, *lq2, *lk2, *g_da; bf16_t* OD; };
__global__ void __launch_bounds__(256) k_attn(AttnP p) {
    __shared__ __attribute__((aligned(16))) bf16_t Ks[64][136];
    __shared__ __attribute__((aligned(16))) bf16_t Vs[64][136];
    __shared__ __attribute__((aligned(16))) bf16_t Qs[32][136];
    __shared__ float As[32][65];
    __shared__ float btab[192];
    __shared__ float lam_s;
    const int tid = threadIdx.x; int bid = blockIdx.x;
    int sample, b, h, q0pos, qrow0, nk;
    if (bid < 16 * 4 * 64) { sample = 0; const int qb = bid & 63; h = (bid >> 6) & 3; b = bid >> 8; q0pos = qb * 32; qrow0 = b * TP + qb * 32; nk = ((qb >> 1) + 1) * 64; }
    else { bid -= 16 * 4 * 64; sample = 1; h = bid & 3; b = bid >> 2; q0pos = PAST; qrow0 = MP + b * TS; nk = PAST + TS; }
    if (tid < 192) btab[tid] = p.rel_bias[t5_bucket(tid - 127) * 4 + h];
    if (tid == 0) { float a = 0.f, c = 0.f; for (int i = 0; i < 64; ++i) { a += p.lq1[i] * p.lk1[i]; c += p.lq2[i] * p.lk2[i]; } lam_s = __expf(a) - __expf(c) + LAM_INIT; }
    for (int e = tid; e < 32 * 128; e += 256) { const int r = e >> 7, c = e & 127; Qs[r][c] = p.QD[(size_t)(qrow0 + r) * 512 + h * 128 + c]; }
    const int qi = tid >> 3, part = tid & 7; const int qpos = q0pos + qi;
    const int ntile = (nk + 63) / 64;
    float m1 = -1e30f, l1 = 0.f, m2 = -1e30f, l2 = 0.f;
    float o[16];
#pragma unroll
    for (int i = 0; i < 16; ++i) o[i] = 0.f;
    for (int sweep = 0; sweep < 2; ++sweep) {
        for (int tl = 0; tl < ntile; ++tl) {
            __syncthreads();
            for (int e = tid; e < 64 * 128; e += 256) { const int r = e >> 7, c = e & 127; const int j = tl * 64 + r; bf16_t kv = 0, vv = 0;
                if (j < nk) {
                    if (!sample) { const size_t row = (size_t)b * TP + j; kv = p.KD[row * 512 + h * 128 + c]; vv = p.VD[row * 512 + h * 128 + c]; }
                    else if (j < PAST) { const size_t o_ = (((size_t)b * PAST + j) * 4 + h) * 128 + c; kv = f2bf(p.ck[o_]); vv = f2bf(p.cv[o_]); }
                    else { const size_t row = (size_t)MP + b * TS + (j - PAST); kv = p.KD[row * 512 + h * 128 + c]; vv = p.VD[row * 512 + h * 128 + c]; }
                }
                Ks[r][c] = kv; Vs[r][c] = vv; }
            __syncthreads();
            float s1[8], s2[8];
#pragma unroll
            for (int kk = 0; kk < 8; ++kk) { const int r = part * 8 + kk; float a1 = 0.f, a2 = 0.f;
                for (int d = 0; d < 64; ++d) { a1 += bf2f(Qs[qi][d]) * bf2f(Ks[r][d]); a2 += bf2f(Qs[qi][64 + d]) * bf2f(Ks[r][64 + d]); }
                const int j = tl * 64 + r; const int rel = j - qpos; const float bias = rel < -127 ? btab[0] : btab[rel + 127];
                s1[kk] = j < nk ? a1 + bias : -1e30f; s2[kk] = j < nk ? a2 + bias : -1e30f; }
            if (sweep == 0) {
#pragma unroll
                for (int kk = 0; kk < 8; ++kk) {
                    if (s1[kk] > -1e29f) { if (s1[kk] > m1) { l1 = l1 * __expf(m1 - s1[kk]) + 1.f; m1 = s1[kk]; } else l1 += __expf(s1[kk] - m1); }
                    if (s2[kk] > -1e29f) { if (s2[kk] > m2) { l2 = l2 * __expf(m2 - s2[kk]) + 1.f; m2 = s2[kk]; } else l2 += __expf(s2[kk] - m2); } }
            } else {
                const float lam = lam_s;
#pragma unroll
                for (int kk = 0; kk < 8; ++kk) { const float a = s1[kk] > -1e29f ? __expf(s1[kk] - m1) * l1 - lam * __expf(s2[kk] - m2) * l2 : 0.f; As[qi][part * 8 + kk] = a; }
                __syncthreads();
                for (int r = 0; r < 64; ++r) { const float a = As[qi][r];
#pragma unroll
                    for (int i = 0; i < 16; ++i) o[i] += a * bf2f(Vs[r][part * 16 + i]); }
            }
        }
        if (sweep == 0) {
            float M1 = m1, M2 = m2;
#pragma unroll
            for (int of = 1; of < 8; of <<= 1) { M1 = fmaxf(M1, __shfl_xor(M1, of)); M2 = fmaxf(M2, __shfl_xor(M2, of)); }
            float L1 = l1 * __expf(m1 - M1), L2 = l2 * __expf(m2 - M2);
#pragma unroll
            for (int of = 1; of < 8; of <<= 1) { L1 += __shfl_xor(L1, of); L2 += __shfl_xor(L2, of); }
            m1 = M1; m2 = M2; l1 = 1.f / L1; l2 = 1.f / L2;
        }
    }
    float ss = 0.f;
#pragma unroll
    for (int i = 0; i < 16; ++i) ss += o[i] * o[i];
#pragma unroll
    for (int of = 1; of < 8; of <<= 1) ss += __shfl_xor(ss, of);
    const float rstd = rsqrtf(ss * (1.f / 128.f) + EPS) * (1.f - LAM_INIT);
#pragma unroll
    for (int i = 0; i < 16; ++i) p.OD[(size_t)(qrow0 + qi) * 512 + h * 128 + part * 16 + i] = f2bf(o[i] * rstd * p.g_da[part * 16 + i]);
}

struct RetP { const bf16_t *QR, *KR, *VR, *GRS; const float *s0, *g_rt; bf16_t* OR; float *rp, *rs; };
__global__ void __launch_bounds__(256) k_ret(RetP p) {
    __shared__ float qs[128], ks[128], vs[128], part[2][128], red[2];
    const int tid = threadIdx.x, e = tid & 127, dh = tid >> 7; int bid = blockIdx.x;
    int sample, b, h, row0, T;
    if (bid < 64) { sample = 0; h = bid & 3; b = bid >> 2; row0 = b * TP; T = TP; } else { bid -= 64; sample = 1; h = bid & 3; b = bid >> 2; row0 = MP + b * TS; T = TS; }
    const float gamma = 1.f - exp2f(-5.f - (float)h);
    float S[64];
#pragma unroll
    for (int i = 0; i < 64; ++i) S[i] = sample ? p.s0[(((size_t)b * 4 + h) * 128 + dh * 64 + i) * 128 + e] : 0.f;
    for (int n = 0; n < T; ++n) {
        const size_t base = (size_t)(row0 + n) * 512 + h * 128;
        __syncthreads();
        if (tid < 128) { qs[tid] = bf2f(p.QR[base + tid]); ks[tid] = bf2f(p.KR[base + tid]); } else { vs[tid - 128] = bf2f(p.VR[base + tid - 128]); }
        __syncthreads();
        const float ve = vs[e]; float po = 0.f;
#pragma unroll
        for (int i = 0; i < 64; ++i) { S[i] = gamma * S[i] + ks[dh * 64 + i] * ve; po += qs[dh * 64 + i] * S[i]; }
        part[dh][e] = po;
        __syncthreads();
        float ov = 0.f, sq = 0.f;
        if (tid < 128) { ov = part[0][e] + part[1][e]; sq = ov * ov; }
#pragma unroll
        for (int of = 1; of < 64; of <<= 1) sq += __shfl_xor(sq, of);
        if (tid < 128 && (tid & 63) == 0) red[tid >> 6] = sq;
        __syncthreads();
        if (tid < 128) { const float rstd = rsqrtf((red[0] + red[1]) * (1.f / 128.f) + EPS);
            p.OR[base + e] = f2bf(ov * rstd * p.g_rt[e] * bf2f(p.GRS[base + e])); }
    }
    float* so = sample ? p.rs : p.rp;
#pragma unroll
    for (int i = 0; i < 64; ++i) so[(((size_t)b * 4 + h) * 128 + dh * 64 + i) * 128 + e] = S[i];
}

struct ConvP { const bf16_t *G, *U; const float *sc, *cw, *cb; bf16_t* ACT; float *cp, *cs; };
__global__ void __launch_bounds__(256) k_conv(ConvP p) {
    const int m = blockIdx.x; int b, t, pos; row_info(m, b, t, pos); const bool sample = m >= MP; const int T = sample ? TS : TP;
    for (int j = threadIdx.x; j < DFF; j += 256) {
        const float g0 = bf2f(p.G[(size_t)m * DFF + j]);
        const float g1 = t >= 1 ? bf2f(p.G[(size_t)(m - 1) * DFF + j]) : (sample ? p.sc[((size_t)b * 2 + 1) * DFF + j] : 0.f);
        const float g2 = t >= 2 ? bf2f(p.G[(size_t)(m - 2) * DFF + j]) : (sample ? p.sc[((size_t)b * 2 + t) * DFF + j] : 0.f);
        const float gc = p.cb[j] + g2 * p.cw[j] + g1 * p.cw[DFF + j] + g0 * p.cw[2 * DFF + j];
        p.ACT[(size_t)m * DFF + j] = f2bf(gelu_tanh(gc) * bf2f(p.U[(size_t)m * DFF + j]));
        if (t >= T - 2) { float* co = sample ? p.cs : p.cp; co[((size_t)b * 2 + (t - (T - 2))) * DFF + j] = g0; }
    }
}

extern "C" void kernel_launch(void* const* d_in, const int* in_sizes, int n_in, void* d_out, int out_size, void* d_ws, size_t ws_size, hipStream_t stream) {
    const float* x_p = (const float*)d_in[0]; const float* x_s = (const float*)d_in[1]; const float* p_p = (const float*)d_in[2]; const float* p_s = (const float*)d_in[3];
    const float* cache_k = (const float*)d_in[4]; const float* cache_v = (const float*)d_in[5]; const float* state_ret = (const float*)d_in[6]; const float* state_conv = (const float*)d_in[7];
    const float* rel_bias = (const float*)d_in[8]; const float* g_mix = (const float*)d_in[9]; const float* w_in = (const float*)d_in[10]; const float* g_q = (const float*)d_in[11];
    const float* g_k = (const float*)d_in[12]; const float* lq1 = (const float*)d_in[13]; const float* lk1 = (const float*)d_in[14]; const float* lq2 = (const float*)d_in[15];
    const float* lk2 = (const float*)d_in[16]; const float* g_da = (const float*)d_in[17]; const float* g_rt = (const float*)d_in[18]; const float* w_bd = (const float*)d_in[19];
    const float* w_br = (const float*)d_in[20]; const float* w_o = (const float*)d_in[21]; const float* g_ffn = (const float*)d_in[22]; const float* w_g = (const float*)d_in[23];
    const float* w_u = (const float*)d_in[24]; const float* conv_w = (const float*)d_in[25]; const float* conv_b = (const float*)d_in[26]; const float* w_d = (const float*)d_in[27];
    const float* g_pe = (const float*)d_in[28]; const float* w_pe = (const float*)d_in[29]; const float* w_pg = (const float*)d_in[30];
    float* out = (float*)d_out;
    float* y = out;
    float* k_p = out + (size_t)M * D;
    float* v_p = k_p + (size_t)MP * 512;
    float* r_p = v_p + (size_t)MP * 512;
    float* c_p = r_p + (size_t)16 * 4 * 128 * 128;
    float* k_s = c_p + (size_t)16 * 2 * DFF;
    float* v_s = k_s + (size_t)MS * 512;
    float* r_s = v_s + (size_t)MS * 512;
    float* c_s = r_s + (size_t)32 * 4 * 128 * 128;
    unsigned char* ws = (unsigned char*)d_ws; size_t off = 0;
    auto carve = [&](size_t bytes) { unsigned char* p = ws + off; off += (bytes + 255) & ~(size_t)255; return p; };
    unsigned char* regA = carve((size_t)M * DIN * 2);
    unsigned char* regB = carve((size_t)M * DIN * 2);
    bf16_t* XN = (bf16_t*)carve((size_t)M * D * 2);
    bf16_t* OD = (bf16_t*)carve((size_t)M * 512 * 2);
    bf16_t* ORb = (bf16_t*)carve((size_t)M * 512 * 2);
    float* H1 = (float*)carve((size_t)M * D * 4);
    bf16_t* PEB = (bf16_t*)carve((size_t)M * PE * 2);
    if (off > ws_size) { fprintf(stderr, "kernel_launch: workspace too small: need %zu have %zu\n", off, ws_size); return; }
    bf16_t* Z = (bf16_t*)regA; float* T1 = (float*)regA; bf16_t* MIX = (bf16_t*)(regA + (size_t)M * D * 4);
    bf16_t* G = (bf16_t*)regA; bf16_t* U = G + (size_t)M * DFF;
    bf16_t* QD = (bf16_t*)regB; bf16_t* KD = QD + (size_t)M * 512; bf16_t* VD = KD + (size_t)M * 512; bf16_t* QR = VD + (size_t)M * 512; bf16_t* KR = QR + (size_t)M * 512;
    bf16_t* VR = KR + (size_t)M * 512; bf16_t* GRS = VR + (size_t)M * 512; bf16_t* GD = GRS + (size_t)M * 512; bf16_t* GT = GD + (size_t)M * D;
    bf16_t* ACT = (bf16_t*)regB; float* TPE = (float*)(regB + (size_t)M * DFF * 2);

    const dim3 blk(256);
    k_rmsnorm<<<M / 4, blk, 0, stream>>>(x_p, x_s, g_mix, XN);
    k_gemm<EpiBf16><<<dim3(DIN / 64, M / 64), blk, 0, stream>>>(GemmArgs{XN, w_in, D, DIN, D, 0}, EpiBf16{Z, DIN, 0});
    { PostIn p{Z, g_q, g_k, QD, KD, VD, QR, KR, VR, GRS, GD, GT, k_p, k_s, v_p, v_s}; k_post_in<<<M, blk, 0, stream>>>(p); }
    { AttnP p{QD, KD, VD, cache_k, cache_v, rel_bias, lq1, lk1, lq2, lk2, g_da, OD}; k_attn<<<16 * 4 * 64 + 32 * 4, blk, 0, stream>>>(p); }
    { RetP p{QR, KR, VR, GRS, state_ret, g_rt, ORb, r_p, r_s}; k_ret<<<64 + 128, blk, 0, stream>>>(p); }
    k_gemm<EpiGate><<<dim3(D / 64, M / 64), blk, 0, stream>>>(GemmArgs{OD, w_bd, 512, D, 512, 0}, EpiGate{GD, T1});
    k_gemm<EpiMix><<<dim3(D / 64, M / 64), blk, 0, stream>>>(GemmArgs{ORb, w_br, 512, D, 512, 0}, EpiMix{T1, GT, MIX});
    k_gemm<EpiRes><<<dim3(D / 64, M / 64), blk, 0, stream>>>(GemmArgs{MIX, w_o, D, D, D, 0}, EpiRes{x_p, x_s, H1});
    k_rmsnorm<<<M / 4, blk, 0, stream>>>(H1, H1 + (size_t)MP * D, g_ffn, XN);
    k_gemm<EpiBf16><<<dim3(DFF / 64, M / 64), blk, 0, stream>>>(GemmArgs{XN, w_g, D, DFF, D, 0}, EpiBf16{G, DFF, 0});
    k_gemm<EpiBf16><<<dim3(DFF / 64, M / 64), blk, 0, stream>>>(GemmArgs{XN, w_u, D, DFF, D, 0}, EpiBf16{U, DFF, 0});
    { ConvP p{G, U, state_conv, conv_w, conv_b, ACT, c_p, c_s}; k_conv<<<M, blk, 0, stream>>>(p); }
    k_gemm<EpiRes><<<dim3(D / 64, M / 64), blk, 0, stream>>>(GemmArgs{ACT, w_d, DFF, D, DFF, 0}, EpiRes{H1, H1 + (size_t)MP * D, y});
    k_rmsnorm<<<M / 4, blk, 0, stream>>>(y, y + (size_t)MP * D, g_pe, XN);
    k_cvt_pe<<<(M * PE / 4 + 255) / 256, blk, 0, stream>>>(p_p, p_s, PEB);
    k_gemm<EpiF32><<<dim3(D / 64, M / 64), blk, 0, stream>>>(GemmArgs{PEB, w_pe, PE, D, PE, 0}, EpiF32{TPE, D, 0});
    k_gemm<EpiFinal><<<dim3(D / 64, M / 64), blk, 0, stream>>>(GemmArgs{XN, w_pg, D, D, D, 0}, EpiFinal{y, TPE});
}
```

```cpp
#include <hip/hip_runtime.h>
#include <stdint.h>
#include <cstdio>

typedef unsigned short bf16_t;
typedef short bf16x8 __attribute__((ext_vector_type(8)));
typedef float f32x4 __attribute__((ext_vector_type(4)));

constexpr int D = 1024, MP = 32768, MS = 1024, M = MP + MS, TP = 2048, TS = 32, PAST = 4096;
constexpr int DIN = 5632, DFF = 2816, PE = 256;
constexpr float EPS = 1e-6f;
constexpr float LAM_INIT = 0.2f;

__device__ __forceinline__ unsigned short f2bf(float f) { unsigned u = __float_as_uint(f); return (unsigned short)((u + 0x7fffu + ((u >> 16) & 1u)) >> 16); }
__device__ __forceinline__ float bf2f(unsigned short b) { return __uint_as_float(((unsigned)b) << 16); }
__device__ __forceinline__ float sigmoidf_(float x) { return 1.f / (1.f + __expf(-x)); }
__device__ __forceinline__ float gelu_tanh(float x) { const float u = 0.7978845608028654f * (x + 0.044715f * x * x * x); return 0.5f * x * (1.f + tanhf(u)); }
__device__ __forceinline__ void row_info(int m, int& b, int& t, int& pos) {
    if (m < MP) { b = m >> 11; t = m & 2047; pos = t; } else { const int ms = m - MP; b = ms >> 5; t = ms & 31; pos = PAST + t; }
}
__device__ __forceinline__ int t5_bucket(int rel) {
    const int ret = rel > 0 ? 16 : 0; const int n = rel < 0 ? -rel : rel;
    int v;
    if (n < 8) v = n; else if (n < 12) v = 8; else if (n < 16) v = 9; else if (n < 23) v = 10; else if (n < 32) v = 11; else if (n < 46) v = 12; else if (n < 64) v = 13; else if (n < 91) v = 14; else v = 15;
    return ret + v;
}

__global__ void __launch_bounds__(256) k_rmsnorm(const float* __restrict__ xp, const float* __restrict__ xs, const float* __restrict__ g, bf16_t* __restrict__ out) {
    const int row = (blockIdx.x * 256 + threadIdx.x) >> 6, lane = threadIdx.x & 63;
    if (row >= M) return;
    const float* xr = row < MP ? xp + (size_t)row * D : xs + (size_t)(row - MP) * D;
    float4 v[4]; float ss = 0.f;
#pragma unroll
    for (int j = 0; j < 4; ++j) { v[j] = ((const float4*)xr)[lane + 64 * j]; ss += v[j].x * v[j].x + v[j].y * v[j].y + v[j].z * v[j].z + v[j].w * v[j].w; }
#pragma unroll
    for (int o = 1; o < 64; o <<= 1) ss += __shfl_xor(ss, o);
    const float rstd = rsqrtf(ss * (1.f / D) + EPS);
#pragma unroll
    for (int j = 0; j < 4; ++j) { const float4 gv = ((const float4*)g)[lane + 64 * j];
        ushort4 o; o.x = f2bf(v[j].x * rstd * gv.x); o.y = f2bf(v[j].y * rstd * gv.y); o.z = f2bf(v[j].z * rstd * gv.z); o.w = f2bf(v[j].w * rstd * gv.w);
        ((ushort4*)(out + (size_t)row * D))[lane + 64 * j] = o; }
}
__global__ void __launch_bounds__(256) k_cvt_pe(const float* __restrict__ pp, const float* __restrict__ ps, bf16_t* __restrict__ out) {
    const size_t i = (size_t)blockIdx.x * 256 + threadIdx.x;
    if (i >= (size_t)M * PE / 4) return;
    const size_t e = i * 4; const float4 v = e < (size_t)MP * PE ? ((const float4*)pp)[i] : ((const float4*)ps)[i - (size_t)MP * PE / 4];
    ushort4 o; o.x = f2bf(v.x); o.y = f2bf(v.y); o.z = f2bf(v.z); o.w = f2bf(v.w); ((ushort4*)out)[i] = o;
}

struct GemmArgs { const bf16_t* A; const float* W; int lda, N, K, pad; };
template <class Epi>
__global__ void __launch_bounds__(256) k_gemm(GemmArgs ga, Epi epi) {
    const bf16_t* __restrict__ A = ga.A; const float* __restrict__ W = ga.W; const int lda = ga.lda, N = ga.N, K = ga.K;
    __shared__ __attribute__((aligned(16))) bf16_t As[64][40];
    __shared__ __attribute__((aligned(16))) bf16_t Bs[64][40];
    const int tid = threadIdx.x, lane = tid & 63, w = tid >> 6, fr = lane & 15, fq = lane >> 4;
    const int n0 = blockIdx.x * 64, m0 = blockIdx.y * 64;
    f32x4 acc[4];
#pragma unroll
    for (int i = 0; i < 4; ++i) acc[i] = (f32x4){0.f, 0.f, 0.f, 0.f};
    const int ar = tid >> 2, ac = (tid & 3) * 8;
    const int wk = tid >> 3, wn = (tid & 7) * 8;
    for (int k0 = 0; k0 < K; k0 += 32) {
        const uint4 av = *(const uint4*)(A + (size_t)(m0 + ar) * lda + k0 + ac);
        const float4 w0 = *(const float4*)(W + (size_t)(k0 + wk) * N + n0 + wn), w1 = *(const float4*)(W + (size_t)(k0 + wk) * N + n0 + wn + 4);
        __syncthreads();
        *(uint4*)&As[ar][ac] = av;
        Bs[wn + 0][wk] = f2bf(w0.x); Bs[wn + 1][wk] = f2bf(w0.y); Bs[wn + 2][wk] = f2bf(w0.z); Bs[wn + 3][wk] = f2bf(w0.w);
        Bs[wn + 4][wk] = f2bf(w1.x); Bs[wn + 5][wk] = f2bf(w1.y); Bs[wn + 6][wk] = f2bf(w1.z); Bs[wn + 7][wk] = f2bf(w1.w);
        __syncthreads();
        const bf16x8 a = *(const bf16x8*)&As[16 * w + fr][8 * fq];
#pragma unroll
        for (int nt = 0; nt < 4; ++nt) { const bf16x8 b = *(const bf16x8*)&Bs[16 * nt + fr][8 * fq]; acc[nt] = __builtin_amdgcn_mfma_f32_16x16x32_bf16(a, b, acc[nt], 0, 0, 0); }
    }
#pragma unroll
    for (int nt = 0; nt < 4; ++nt)
#pragma unroll
        for (int j = 0; j < 4; ++j) epi(m0 + 16 * w + fq * 4 + j, n0 + 16 * nt + fr, acc[nt][j]);
}
struct EpiBf16 { bf16_t* out; int ld; int pad; __device__ void operator()(int r, int c, float v) const { out[(size_t)r * ld + c] = f2bf(v); } };
struct EpiF32 { float* out; int ld; int pad; __device__ void operator()(int r, int c, float v) const { out[(size_t)r * ld + c] = v; } };
struct EpiGate { const bf16_t* gate; float* out; __device__ void operator()(int r, int c, float v) const { const size_t i = (size_t)r * D + c; out[i] = v * bf2f(gate[i]); } };
struct EpiMix { const float* t1; const bf16_t* gate; bf16_t* out; __device__ void operator()(int r, int c, float v) const { const size_t i = (size_t)r * D + c; out[i] = f2bf(t1[i] + v * bf2f(gate[i])); } };
struct EpiRes { const float* rp; const float* rs; float* out; __device__ void operator()(int r, int c, float v) const {
    const float res = r < MP ? rp[(size_t)r * D + c] : rs[(size_t)(r - MP) * D + c]; out[(size_t)r * D + c] = res + v; } };
struct EpiFinal { float* y; const float* tpe; __device__ void operator()(int r, int c, float v) const { const size_t i = (size_t)r * D + c; y[i] = y[i] + tpe[i] * sigmoidf_(v); } };

struct PostIn { const bf16_t* Z; const float *g_q, *g_k; bf16_t *QD, *KD, *VD, *QR, *KR, *VR, *GRS, *GD, *GT; float *kp, *ks, *vp, *vs; };
__global__ void __launch_bounds__(256) k_post_in(PostIn p) {
    const int m = blockIdx.x, tid = threadIdx.x; int b, t, pos; row_info(m, b, t, pos);
    const bf16_t* z = p.Z + (size_t)m * DIN;
    float* kout = m < MP ? p.kp + (size_t)m * 512 : p.ks + (size_t)(m - MP) * 512;
    float* vout = m < MP ? p.vp + (size_t)m * 512 : p.vs + (size_t)(m - MP) * 512;
    {
        const int c = tid * 2; const float q0 = bf2f(z[c]), q1 = bf2f(z[c + 1]), k0 = bf2f(z[512 + c]), k1 = bf2f(z[512 + c + 1]);
        float sq = q0 * q0 + q1 * q1, sk = k0 * k0 + k1 * k1;
#pragma unroll
        for (int o = 1; o < 32; o <<= 1) { sq += __shfl_xor(sq, o); sk += __shfl_xor(sk, o); }
        const float rq = rsqrtf(sq * (1.f / 64.f) + EPS) * 0.125f, rk = rsqrtf(sk * (1.f / 64.f) + EPS);
        const int d = c & 63;
        p.QD[(size_t)m * 512 + c] = f2bf(q0 * rq * p.g_q[d]); p.QD[(size_t)m * 512 + c + 1] = f2bf(q1 * rq * p.g_q[d + 1]);
        const float kn0 = k0 * rk * p.g_k[d], kn1 = k1 * rk * p.g_k[d + 1];
        p.KD[(size_t)m * 512 + c] = f2bf(kn0); p.KD[(size_t)m * 512 + c + 1] = f2bf(kn1); kout[c] = kn0; kout[c + 1] = kn1;
        const float v0 = bf2f(z[1024 + c]), v1 = bf2f(z[1024 + c + 1]);
        p.VD[(size_t)m * 512 + c] = z[1024 + c]; p.VD[(size_t)m * 512 + c + 1] = z[1024 + c + 1]; vout[c] = v0; vout[c + 1] = v1;
    }
    {
        const int h = tid >> 6, i = tid & 63;
        const float inv = powf(10000.f, -(float)i / 64.f); const float ang = (float)pos * inv; float sn, cs; sincosf(ang, &sn, &cs);
        const float q1 = bf2f(z[1536 + h * 128 + i]), q2 = bf2f(z[1536 + h * 128 + 64 + i]);
        p.QR[(size_t)m * 512 + h * 128 + i] = f2bf(q1 * cs - q2 * sn); p.QR[(size_t)m * 512 + h * 128 + 64 + i] = f2bf(q1 * sn + q2 * cs);
        const float k1 = bf2f(z[2048 + h * 128 + i]), k2 = bf2f(z[2048 + h * 128 + 64 + i]); const float sc = 0.08838834764831845f;
        p.KR[(size_t)m * 512 + h * 128 + i] = f2bf((k1 * cs - k2 * sn) * sc); p.KR[(size_t)m * 512 + h * 128 + 64 + i] = f2bf((k1 * sn + k2 * cs) * sc);
    }
    for (int c = tid; c < 512; c += 256) { p.VR[(size_t)m * 512 + c] = z[2560 + c]; const float g = bf2f(z[3072 + c]); p.GRS[(size_t)m * 512 + c] = f2bf(g * sigmoidf_(g)); }
    for (int c = tid; c < 1024; c += 256) { p.GD[(size_t)m * D + c] = f2bf(sigmoidf_(bf2f(z[3584 + c]))); p.GT[(size_t)m * D + c] = f2bf(sigmoidf_(bf2f(z[4608 + c]))); }
}

struct AttnP { const bf16_t *QD, *KD, *VD; const float *ck, *cv, *rel_bias, *lq1, *lk1, *lq2, *lk2, *g_da; bf16_t* OD; };
__global__ void __launch_bounds__(256) k_attn(AttnP p) {
    __shared__ __attribute__((aligned(16))) bf16_t Ks[64][136];
    __shared__ __attribute__((aligned(16))) bf16_t Vs[64][136];
    __shared__ __attribute__((aligned(16))) bf16_t Qs[32][136];
    __shared__ float As[32][65];
    __shared__ float btab[192];
    __shared__ float lam_s;
    const int tid = threadIdx.x; int bid = blockIdx.x;
    int sample, b, h, q0pos, qrow0, nk;
    if (bid < 16 * 4 * 64) { sample = 0; const int qb = bid & 63; h = (bid >> 6) & 3; b = bid >> 8; q0pos = qb * 32; qrow0 = b * TP + qb * 32; nk = ((qb >> 1) + 1) * 64; }
    else { bid -= 16 * 4 * 64; sample = 1; h = bid & 3; b = bid >> 2; q0pos = PAST; qrow0 = MP + b * TS; nk = PAST + TS; }
    if (tid < 192) btab[tid] = p.rel_bias[t5_bucket(tid - 127) * 4 + h];
    if (tid == 0) { float a = 0.f, c = 0.f; for (int i = 0; i < 64; ++i) { a += p.lq1[i] * p.lk1[i]; c += p.lq2[i] * p.lk2[i]; } lam_s = __expf(a) - __expf(c) + LAM_INIT; }
    for (int e = tid; e < 32 * 128; e += 256) { const int r = e >> 7, c = e & 127; Qs[r][c] = p.QD[(size_t)(qrow0 + r) * 512 + h * 128 + c]; }
    const int qi = tid >> 3, part = tid & 7; const int qpos = q0pos + qi;
    const int ntile = (nk + 63) / 64;
    float m1 = -1e30f, l1 = 0.f, m2 = -1e30f, l2 = 0.f;
    float o[16];
#pragma unroll
    for (int i = 0; i < 16; ++i) o[i] = 0.f;
    for (int sweep = 0; sweep < 2; ++sweep) {
        for (int tl = 0; tl < ntile; ++tl) {
            __syncthreads();
            for (int e = tid; e < 64 * 128; e += 256) { const int r = e >> 7, c = e & 127; const int j = tl * 64 + r; bf16_t kv = 0, vv = 0;
                if (j < nk) {
                    if (!sample) { const size_t row = (size_t)b * TP + j; kv = p.KD[row * 512 + h * 128 + c]; vv = p.VD[row * 512 + h * 128 + c]; }
                    else if (j < PAST) { const size_t o_ = (((size_t)b * PAST + j) * 4 + h) * 128 + c; kv = f2bf(p.ck[o_]); vv = f2bf(p.cv[o_]); }
                    else { const size_t row = (size_t)MP + b * TS + (j - PAST); kv = p.KD[row * 512 + h * 128 + c]; vv = p.VD[row * 512 + h * 128 + c]; }
                }
                Ks[r][c] = kv; Vs[r][c] = vv; }
            __syncthreads();
            float s1[8], s2[8];
#pragma unroll
            for (int kk = 0; kk < 8; ++kk) { const int r = part * 8 + kk; float a1 = 0.f, a2 = 0.f;
                for (int d = 0; d < 64; ++d) { a1 += bf2f(Qs[qi][d]) * bf2f(Ks[r][d]); a2 += bf2f(Qs[qi][64 + d]) * bf2f(Ks[r][64 + d]); }
                const int j = tl * 64 + r; const int rel = j - qpos; const float bias = rel < -127 ? btab[0] : btab[rel + 127];
                s1[kk] = j < nk ? a1 + bias : -1e30f; s2[kk] = j < nk ? a2 + bias : -1e30f; }
            if (sweep == 0) {
#pragma unroll
                for (int kk = 0; kk < 8; ++kk) {
                    if (s1[kk] > -1e29f) { if (s1[kk] > m1) { l1 = l1 * __expf(m1 - s1[kk]) + 1.f; m1 = s1[kk]; } else l1 += __expf(s1[kk] - m1); }
                    if (s2[kk] > -1e29f) { if (s2[kk] > m2) { l2 = l2 * __expf(m2 - s2[kk]) + 1.f; m2 = s2[kk]; } else l2 += __expf(s2[kk] - m2); } }
            } else {
                const float lam = lam_s;
#pragma unroll
                for (int kk = 0; kk < 8; ++kk) { const float a = s1[kk] > -1e29f ? __expf(s1[kk] - m1) * l1 - lam * __expf(s2[kk] - m2) * l2 : 0.f; As[qi][part * 8 + kk] = a; }
                __syncthreads();
                for (int r = 0; r < 64; ++r) { const float a = As[qi][r];
#pragma unroll
                    for (int i = 0; i < 16; ++i) o[i] += a * bf2f(Vs[r][part * 16 + i]); }
            }
        }
        if (sweep == 0) {
            float M1 = m1, M2 = m2;
#pragma unroll
            for (int of = 1; of < 8; of <<= 1) { M1 = fmaxf(M1, __shfl_xor(M1, of)); M2 = fmaxf(M2, __shfl_xor(M2, of)); }
            float L1 = l1 * __expf(m1 - M1), L2 = l2 * __expf(m2 - M2);
#pragma unroll
            for (int of = 1; of < 8; of <<= 1) { L1 += __shfl_xor(L1, of); L2 += __shfl_xor(L2, of); }
            m1 = M1; m2 = M2; l1 = 1.f / L1; l2 = 1.f / L2;
        }
    }
    float ss = 0.f;
#pragma unroll
    for (int i = 0; i < 16; ++i) ss += o[i] * o[i];
#pragma unroll
    for (int of = 1; of < 8; of <<= 1) ss += __shfl_xor(ss, of);
    const float rstd = rsqrtf(ss * (1.f / 128.f) + EPS) * (1.f - LAM_INIT);
#pragma unroll
    for (int i = 0; i < 16; ++i) p.OD[(size_t)(qrow0 + qi) * 512 + h * 128 + part * 16 + i] = f2bf(o[i] * rstd * p.g_da[part * 16 + i]);
}

struct RetP { const bf16_t *QR, *KR, *VR, *GRS; const float *s0, *g_rt; bf16_t* OR; float *rp, *rs; };
__global__ void __launch_bounds__(256) k_ret(RetP p) {
    __shared__ float qs[128], ks[128], vs[128], part[2][128], red[2];
    const int tid = threadIdx.x, e = tid & 127, dh = tid >> 7; int bid = blockIdx.x;
    int sample, b, h, row0, T;
    if (bid < 64) { sample = 0; h = bid & 3; b = bid >> 2; row0 = b * TP; T = TP; } else { bid -= 64; sample = 1; h = bid & 3; b = bid >> 2; row0 = MP + b * TS; T = TS; }
    const float gamma = 1.f - exp2f(-5.f - (float)h);
    float S[64];
#pragma unroll
    for (int i = 0; i < 64; ++i) S[i] = sample ? p.s0[(((size_t)b * 4 + h) * 128 + dh * 64 + i) * 128 + e] : 0.f;
    for (int n = 0; n < T; ++n) {
        const size_t base = (size_t)(row0 + n) * 512 + h * 128;
        __syncthreads();
        if (tid < 128) { qs[tid] = bf2f(p.QR[base + tid]); ks[tid] = bf2f(p.KR[base + tid]); } else { vs[tid - 128] = bf2f(p.VR[base + tid - 128]); }
        __syncthreads();
        const float ve = vs[e]; float po = 0.f;
#pragma unroll
        for (int i = 0; i < 64; ++i) { S[i] = gamma * S[i] + ks[dh * 64 + i] * ve; po += qs[dh * 64 + i] * S[i]; }
        part[dh][e] = po;
        __syncthreads();
        float ov = 0.f, sq = 0.f;
        if (tid < 128) { ov = part[0][e] + part[1][e]; sq = ov * ov; }
#pragma unroll
        for (int of = 1; of < 64; of <<= 1) sq += __shfl_xor(sq, of);
        if (tid < 128 && (tid & 63) == 0) red[tid >> 6] = sq;
        __syncthreads();
        if (tid < 128) { const float rstd = rsqrtf((red[0] + red[1]) * (1.f / 128.f) + EPS);
            p.OR[base + e] = f2bf(ov * rstd * p.g_rt[e] * bf2f(p.GRS[base + e])); }
    }
    float* so = sample ? p.rs : p.rp;
#pragma unroll
    for (int i = 0; i < 64; ++i) so[(((size_t)b * 4 + h) * 128 + dh * 64 + i) * 128 + e] = S[i];
}

struct ConvP { const bf16_t *G, *U; const float *sc, *cw, *cb; bf16_t* ACT; float *cp, *cs; };
__global__ void __launch_bounds__(256) k_conv(ConvP p) {
    const int m = blockIdx.x; int b, t, pos; row_info(m, b, t, pos); const bool sample = m >= MP; const int T = sample ? TS : TP;
    for (int j = threadIdx.x; j < DFF; j += 256) {
        const float g0 = bf2f(p.G[(size_t)m * DFF + j]);
        const float g1 = t >= 1 ? bf2f(p.G[(size_t)(m - 1) * DFF + j]) : (sample ? p.sc[((size_t)b * 2 + 1) * DFF + j] : 0.f);
        const float g2 = t >= 2 ? bf2f(p.G[(size_t)(m - 2) * DFF + j]) : (sample ? p.sc[((size_t)b * 2 + t) * DFF + j] : 0.f);
        const float gc = p.cb[j] + g2 * p.cw[j] + g1 * p.cw[DFF + j] + g0 * p.cw[2 * DFF + j];
        p.ACT[(size_t)m * DFF + j] = f2bf(gelu_tanh(gc) * bf2f(p.U[(size_t)m * DFF + j]));
        if (t >= T - 2) { float* co = sample ? p.cs : p.cp; co[((size_t)b * 2 + (t - (T - 2))) * DFF + j] = g0; }
    }
}

#include <cstring>
namespace pg8 {
#define PG8_LAS __attribute__((address_space(3)))
typedef unsigned short bf16_t;
typedef short bf16x8 __attribute__((ext_vector_type(8)));
typedef float f32x4 __attribute__((ext_vector_type(4)));
typedef unsigned u32x4 __attribute__((ext_vector_type(4)));
constexpr int BM = 256, BK = 64, HALF = 128, HTB = HALF * BK * 2  , STAGE_BYTES = 8 * HTB, NXCD = 8, WGM = 8;

__host__ __device__ __forceinline__ int lds_byte(int r, int c) { const int st = (r >> 4) * 2 + (c >> 5), rr = r & 15, cc = c & 31, ob = rr * 64 + cc * 2; return st * 1024 + (ob ^ (((ob >> 9) & 1) << 5)); }
__host__ __device__ __forceinline__ void stage_rc(int b, int& R, int& C) { const int st = b / 1024, sb = b % 1024, swz = sb ^ (((sb >> 9) & 1) << 5); R = (st >> 1) * 16 + swz / 64; C = (st & 1) * 32 + (swz % 64) / 2; }
__host__ __device__ __forceinline__ int perm32(int rho) { const int n = rho >> 4, i = rho & 15; return 8 * (i >> 2) + 4 * n + (i & 3); }

struct Unit { int pm, pn; };
struct Gemm { const bf16_t* A; const bf16_t* Bt; int M, N, K; };

struct StaticOrder {
    int nM, nN, nwg, G, c;
    __host__ __device__ void init(int M, int N, int G_, int c_) { nM = M / BM; nN = N / BM; nwg = nM * nN; G = G_; c = c_; }
    __host__ __device__ bool next(int i, Unit& u) const {
        const long L = (long)i * G + c; if (L >= nwg) return false;
        int wgid = (int)L; { const int q = nwg / NXCD, r = nwg % NXCD, xcd = wgid % NXCD, off = wgid / NXCD; wgid = (xcd < r ? xcd * (q + 1) : r * (q + 1) + (xcd - r) * q) + off; }
        const int nig = WGM * nN, gid = wgid / nig, fm = gid * WGM, gsz = (nM - fm) < WGM ? (nM - fm) : WGM;
        u.pm = fm + ((wgid % nig) % gsz); u.pn = (wgid % nig) / gsz; return true;
    }
    __device__ __forceinline__ void a_ready(const Unit&) const {}
    __device__ __forceinline__ void done(const Unit&) const {}
};

__device__ __forceinline__ unsigned cvt_pk_bf16(float lo, float hi) { unsigned r; asm volatile("v_cvt_pk_bf16_f32 %0, %1, %2" : "=v"(r) : "v"(lo), "v"(hi)); return r; }
typedef float f32x2 __attribute__((ext_vector_type(2)));
__device__ __forceinline__ f32x2 gelu_pk(f32x2 v) {
    const f32x2 av = __builtin_elementwise_abs(v), d = av * 0.2316418882f + 1.0f;
    f32x2 t; t.x = __builtin_amdgcn_rcpf(d.x); t.y = __builtin_amdgcn_rcpf(d.y);
    f32x2 q = t * 0.5307027145f + (-0.7265760135f); q = q * t + 0.7107068705f; q = q * t + (-0.142248368f); q = q * t + 0.127414796f; q = q * t;
    const f32x2 s = (v * v) * (-0.72134752044f);
    f32x2 e; e.x = __builtin_amdgcn_exp2f(s.x); e.y = __builtin_amdgcn_exp2f(s.y);
    const f32x2 m = v * (q * e), r = v - m;
    f32x2 o; o.x = v.x < 0.f ? m.x : r.x; o.y = v.y < 0.f ? m.y : r.y; return o;
}


typedef __bf16 bf16x2_t __attribute__((ext_vector_type(2)));
__device__ __forceinline__ unsigned cvtpk(float lo, float hi) { f32x2 v = {lo, hi}; bf16x2_t b = __builtin_convertvector(v, bf16x2_t); return __builtin_bit_cast(unsigned, b); }
__device__ __forceinline__ u32x4 pack8(f32x4 a, f32x4 b) { u32x4 w; w.x = cvtpk(a[0], a[1]); w.y = cvtpk(a[2], a[3]); w.z = cvtpk(b[0], b[1]); w.w = cvtpk(b[2], b[3]); return w; }
__device__ __forceinline__ float fsig(float x) { return __builtin_amdgcn_rcpf(1.f + __builtin_amdgcn_exp2f(-1.4426950408889634f * x)); }
__device__ __forceinline__ f32x4 fsig4(f32x4 x) { return (f32x4){fsig(x[0]), fsig(x[1]), fsig(x[2]), fsig(x[3])}; }

constexpr int E_MP = 32768;
struct EpiIn {
    static constexpr bool PERM = true, AFTER_DRAIN = false;
    bf16_t *QD, *KD, *VD, *QR, *KR, *VR, *GRS, *GD, *GT; float *kp, *ks, *vp, *vs; const float *g_q, *g_k; const float* rot;
    __device__ __forceinline__ void operator()(const f32x4 (&acc)[2][2][4][2], const Unit& u, int wr, int wc, int fr, int fq) const {
        const int pn = u.pn; const int rbase = u.pm * BM + wr * 64 + fr; const bool samp = u.pm >= E_MP / BM;
        if (pn < 4) {
            const bool isq = pn < 2; const float* gg = isq ? g_q : g_k; const float sc = isq ? 0.125f : 1.f;
            f32x4 gv[2][2];
#pragma unroll
            for (int bj = 0; bj < 2; ++bj)
#pragma unroll
                for (int n = 0; n < 2; ++n) gv[bj][n] = *(const f32x4*)(gg + 32 * bj + 8 * fq + 4 * n);
            const int col = (pn & 1) * 256 + 64 * wc + 8 * fq;
            bf16_t* dst = isq ? QD : KD; float* ko = samp ? ks - (size_t)E_MP * 512 : kp;
#pragma unroll
            for (int ai = 0; ai < 2; ++ai)
#pragma unroll
                for (int m = 0; m < 4; ++m) { const size_t row = (size_t)(rbase + ai * HALF + m * 16);
                    float ss = 0.f;
#pragma unroll
                    for (int bj = 0; bj < 2; ++bj)
#pragma unroll
                        for (int n = 0; n < 2; ++n) { const f32x4 x = acc[ai][bj][m][n]; ss += (x[0] * x[0] + x[1] * x[1]) + (x[2] * x[2] + x[3] * x[3]); }
                    ss += __shfl_xor(ss, 16); ss += __shfl_xor(ss, 32);
                    const float rs = __builtin_amdgcn_rsqf(ss * (1.f / 64.f) + 1e-6f) * sc;
#pragma unroll
                    for (int bj = 0; bj < 2; ++bj) { const f32x4 v0 = acc[ai][bj][m][0] * rs * gv[bj][0], v1 = acc[ai][bj][m][1] * rs * gv[bj][1];
                        *(u32x4*)(dst + row * 512 + col + 32 * bj) = pack8(v0, v1);
                        if (!isq) { float* kr_ = ko + row * 512 + col + 32 * bj; *(f32x4*)kr_ = v0; *(f32x4*)(kr_ + 4) = v1; } } }
        } else if (pn < 6) {
            const int col = (pn - 4) * 256 + 32 * wc + 8 * fq; float* vo = samp ? vs - (size_t)E_MP * 512 : vp;
#pragma unroll
            for (int ai = 0; ai < 2; ++ai)
#pragma unroll
                for (int m = 0; m < 4; ++m) { const size_t row = (size_t)(rbase + ai * HALF + m * 16);
#pragma unroll
                    for (int bj = 0; bj < 2; ++bj) { const f32x4 v0 = acc[ai][bj][m][0], v1 = acc[ai][bj][m][1];
                        *(u32x4*)(VD + row * 512 + col + 128 * bj) = pack8(v0, v1);
                        float* vr_ = vo + row * 512 + col + 128 * bj; *(f32x4*)vr_ = v0; *(f32x4*)(vr_ + 4) = v1; } }
        } else if (pn < 10) {
            const bool isq = pn < 8; const int head = (pn & 1) * 2 + (wc >> 1); const int i0 = 32 * (wc & 1) + 8 * fq; const float sc = isq ? 1.f : 0.08838834764831845f;
            bf16_t* dst = isq ? QR : KR;
#pragma unroll
            for (int ai = 0; ai < 2; ++ai)
#pragma unroll
                for (int m = 0; m < 4; ++m) { const int rowi = rbase + ai * HALF + m * 16; const size_t row = (size_t)rowi;
                    const int pidx = samp ? 2048 + ((rowi - E_MP) & 31) : (rowi & 2047);
                    const f32x4* rt = (const f32x4*)(rot + ((size_t)pidx * 64 + i0) * 2);
                    f32x4 o1[2], o2[2];
#pragma unroll
                    for (int n = 0; n < 2; ++n) { const f32x4 ra = rt[2 * n], rb = rt[2 * n + 1]; const f32x4 x1 = acc[ai][0][m][n], x2 = acc[ai][1][m][n];
                        const f32x4 cs = (f32x4){ra[0], ra[2], rb[0], rb[2]}, sn = (f32x4){ra[1], ra[3], rb[1], rb[3]};
                        o1[n] = (x1 * cs - x2 * sn) * sc; o2[n] = (x1 * sn + x2 * cs) * sc; }
                    *(u32x4*)(dst + row * 512 + head * 128 + i0) = pack8(o1[0], o1[1]);
                    *(u32x4*)(dst + row * 512 + head * 128 + 64 + i0) = pack8(o2[0], o2[1]); }
        } else if (pn < 14) {
            const bool isv = pn < 12; const int col = (pn & 1) * 256 + 32 * wc + 8 * fq; bf16_t* dst = isv ? VR : GRS;
#pragma unroll
            for (int ai = 0; ai < 2; ++ai)
#pragma unroll
                for (int m = 0; m < 4; ++m) { const size_t row = (size_t)(rbase + ai * HALF + m * 16);
#pragma unroll
                    for (int bj = 0; bj < 2; ++bj) { f32x4 v0 = acc[ai][bj][m][0], v1 = acc[ai][bj][m][1];
                        if (!isv) { v0 = v0 * fsig4(v0); v1 = v1 * fsig4(v1); }
                        *(u32x4*)(dst + row * 512 + col + 128 * bj) = pack8(v0, v1); } }
        } else {
            const bool isd = pn < 18; const int col = ((pn - 14) & 3) * 256 + 32 * wc + 8 * fq; bf16_t* dst = isd ? GD : GT;
#pragma unroll
            for (int ai = 0; ai < 2; ++ai)
#pragma unroll
                for (int m = 0; m < 4; ++m) { const size_t row = (size_t)(rbase + ai * HALF + m * 16);
#pragma unroll
                    for (int bj = 0; bj < 2; ++bj) { const f32x4 v0 = fsig4(acc[ai][bj][m][0]), v1 = fsig4(acc[ai][bj][m][1]);
                        *(u32x4*)(dst + row * 1024 + col + 128 * bj) = pack8(v0, v1); } }
        }
    }
};
struct EpiResid {
    static constexpr bool PERM = true, AFTER_DRAIN = false;
    const float* rp; const float* rs; float* out;
    __device__ __forceinline__ void operator()(const f32x4 (&acc)[2][2][4][2], const Unit& u, int wr, int wc, int fr, int fq) const {
        const int rbase = u.pm * BM + wr * 64 + fr; const bool samp = u.pm >= E_MP / BM; const int col = u.pn * 256 + 32 * wc + 8 * fq;
        const float* res = samp ? rs - (size_t)E_MP * 1024 : rp;
#pragma unroll
        for (int ai = 0; ai < 2; ++ai)
#pragma unroll
            for (int m = 0; m < 4; ++m) { const size_t row = (size_t)(rbase + ai * HALF + m * 16);
#pragma unroll
                for (int bj = 0; bj < 2; ++bj) { const size_t o = row * 1024 + col + 128 * bj;
                    const f32x4 r0 = *(const f32x4*)(res + o), r1 = *(const f32x4*)(res + o + 4);
                    *(f32x4*)(out + o) = r0 + acc[ai][bj][m][0]; *(f32x4*)(out + o + 4) = r1 + acc[ai][bj][m][1]; } }
    }
};

__device__ __forceinline__ void unpack8(u32x4 w, f32x4& a, f32x4& b) {
    a = (f32x4){__uint_as_float(w.x << 16), __uint_as_float(w.x & 0xffff0000u), __uint_as_float(w.y << 16), __uint_as_float(w.y & 0xffff0000u)};
    b = (f32x4){__uint_as_float(w.z << 16), __uint_as_float(w.z & 0xffff0000u), __uint_as_float(w.w << 16), __uint_as_float(w.w & 0xffff0000u)};
}
struct EpiGateT1 {
    static constexpr bool PERM = true, AFTER_DRAIN = false;
    const bf16_t* gate; float* t1;
    __device__ __forceinline__ void operator()(const f32x4 (&acc)[2][2][4][2], const Unit& u, int wr, int wc, int fr, int fq) const {
        const int rbase = u.pm * BM + wr * 64 + fr; const int col = u.pn * 256 + 32 * wc + 8 * fq;
#pragma unroll
        for (int ai = 0; ai < 2; ++ai)
#pragma unroll
            for (int m = 0; m < 4; ++m) { const size_t row = (size_t)(rbase + ai * HALF + m * 16);
#pragma unroll
                for (int bj = 0; bj < 2; ++bj) { const size_t o = row * 1024 + col + 128 * bj; f32x4 g0, g1; unpack8(*(const u32x4*)(gate + o), g0, g1);
                    *(f32x4*)(t1 + o) = acc[ai][bj][m][0] * g0; *(f32x4*)(t1 + o + 4) = acc[ai][bj][m][1] * g1; } }
    }
};
struct EpiMixOut {
    static constexpr bool PERM = true, AFTER_DRAIN = false;
    const bf16_t* gate; const float* t1; bf16_t* mix;
    __device__ __forceinline__ void operator()(const f32x4 (&acc)[2][2][4][2], const Unit& u, int wr, int wc, int fr, int fq) const {
        const int rbase = u.pm * BM + wr * 64 + fr; const int col = u.pn * 256 + 32 * wc + 8 * fq;
#pragma unroll
        for (int ai = 0; ai < 2; ++ai)
#pragma unroll
            for (int m = 0; m < 4; ++m) { const size_t row = (size_t)(rbase + ai * HALF + m * 16);
#pragma unroll
                for (int bj = 0; bj < 2; ++bj) { const size_t o = row * 1024 + col + 128 * bj; f32x4 g0, g1; unpack8(*(const u32x4*)(gate + o), g0, g1);
                    const f32x4 a0 = *(const f32x4*)(t1 + o) + acc[ai][bj][m][0] * g0, a1 = *(const f32x4*)(t1 + o + 4) + acc[ai][bj][m][1] * g1;
                    *(u32x4*)(mix + o) = pack8(a0, a1); } }
    }
};
struct EpiResNorm {
    static constexpr bool PERM = true, AFTER_DRAIN = false;
    const float* rp; const float* rs; float* hout; bf16_t* hb; float* ss;
    __device__ __forceinline__ void operator()(const f32x4 (&acc)[2][2][4][2], const Unit& u, int wr, int wc, int fr, int fq) const {
        const int rbase = u.pm * BM + wr * 64 + fr; const bool samp = u.pm >= E_MP / BM; const int col = u.pn * 256 + 32 * wc + 8 * fq;
        const float* res = samp ? rs - (size_t)E_MP * 1024 : rp;
#pragma unroll
        for (int ai = 0; ai < 2; ++ai)
#pragma unroll
            for (int m = 0; m < 4; ++m) { const size_t row = (size_t)(rbase + ai * HALF + m * 16); float sq = 0.f;
#pragma unroll
                for (int bj = 0; bj < 2; ++bj) { const size_t o = row * 1024 + col + 128 * bj;
                    const f32x4 h0 = *(const f32x4*)(res + o) + acc[ai][bj][m][0], h1 = *(const f32x4*)(res + o + 4) + acc[ai][bj][m][1];
                    *(f32x4*)(hout + o) = h0; *(f32x4*)(hout + o + 4) = h1; *(u32x4*)(hb + o) = pack8(h0, h1);
                    sq += (h0[0] * h0[0] + h0[1] * h0[1]) + (h0[2] * h0[2] + h0[3] * h0[3]) + (h1[0] * h1[0] + h1[1] * h1[1]) + (h1[2] * h1[2] + h1[3] * h1[3]); }
                sq += __shfl_xor(sq, 16); sq += __shfl_xor(sq, 32);
                if (fq == 0) ss[row * 16 + u.pn * 4 + wc] = sq;
                asm volatile("" ::: "memory"); }
    }
};
__device__ __forceinline__ void rstd_table(PG8_LAS float* tab, const float* ss, int pm) {
    const int tid = threadIdx.x;
    if (tid < 256) { const f32x4* p = (const f32x4*)(ss + (size_t)(pm * BM + tid) * 16); const f32x4 a = p[0], b = p[1], c = p[2], d = p[3];
        const float s = ((a[0] + a[1]) + (a[2] + a[3])) + ((b[0] + b[1]) + (b[2] + b[3])) + ((c[0] + c[1]) + (c[2] + c[3])) + ((d[0] + d[1]) + (d[2] + d[3]));
        tab[tid] = __builtin_amdgcn_rsqf(s * (1.f / 1024.f) + 1e-6f); }
    asm volatile("s_waitcnt lgkmcnt(0)" ::: "memory"); __builtin_amdgcn_s_barrier(); asm volatile("" ::: "memory");
}
__device__ __forceinline__ float gelu_t(float x) {
    const float w = x * (-2.3022082f - 0.10294324f * (x * x)); return x * __builtin_amdgcn_rcpf(1.f + __builtin_amdgcn_exp2f(w));
}
constexpr int E_DFF = 2816;
struct EpiGU {
    static constexpr bool PERM = true, AFTER_DRAIN = false;
    const float* ss; const float* sc; const float* cw; const float* cb; bf16_t* act; float* headp; float* headu; float* tail; float* cp; float* cs; PG8_LAS float* tab;
    __device__ __forceinline__ void operator()(const f32x4 (&acc)[2][2][4][2], const Unit& u, int wr, int wc, int fr, int fq) const {
        rstd_table(tab, ss, u.pm);
        const int lane = threadIdx.x & 63; const bool samp = u.pm >= E_MP / BM;
        const int src1 = (lane & 48) | ((fr + 15) & 15), src2 = (lane & 48) | ((fr + 14) & 15);
#pragma unroll
        for (int n = 0; n < 2; ++n) {
            const int j0 = u.pn * 128 + 32 * wc + 8 * fq + 4 * n;
            const f32x4 w0 = *(const f32x4*)(cw + j0), w1 = *(const f32x4*)(cw + E_DFF + j0), w2 = *(const f32x4*)(cw + 2 * E_DFF + j0), bb = *(const f32x4*)(cb + j0);
#pragma unroll
            for (int ai = 0; ai < 2; ++ai) {
                const int r0t = ai * HALF + wr * 64;
                const int grow0 = u.pm * BM + r0t;
                f32x4 xm1 = (f32x4){0.f, 0.f, 0.f, 0.f};
#pragma unroll
                for (int m = 0; m < 4; ++m) {
                    const int rowi = grow0 + m * 16 + fr; const float rs = tab[r0t + m * 16 + fr];
                    const f32x4 g = acc[ai][0][m][n] * rs, uu = acc[ai][1][m][n] * rs;
                    if (samp && (m & 1) == 0) { const int b = (rowi - fr - E_MP) >> 5; const int sr = fr >= 14 ? fr - 14 : 0; xm1 = *(const f32x4*)(sc + ((size_t)b * 2 + sr) * E_DFF + j0); }
                    f32x4 gc;
#pragma unroll
                    for (int i = 0; i < 4; ++i) { const float y1 = fr == 15 ? xm1[i] : g[i], y2 = fr >= 14 ? xm1[i] : g[i];
                        const float p1 = __shfl(y1, src1), p2 = __shfl(y2, src2);
                        gc[i] = bb[i] + w0[i] * p2 + w1[i] * p1 + w2[i] * g[i]; }
                    const bool head = !samp && m == 0 && fr < 2;
                    if (head) { const size_t o = ((size_t)(grow0 >> 6) * 2 + fr) * E_DFF + j0; *(f32x4*)(headp + o) = gc; *(f32x4*)(headu + o) = uu; }
                    else { uint2 w; w.x = cvtpk(gelu_t(gc[0]) * uu[0], gelu_t(gc[1]) * uu[1]); w.y = cvtpk(gelu_t(gc[2]) * uu[2], gelu_t(gc[3]) * uu[3]);
                        *(uint2*)(act + (size_t)rowi * E_DFF + j0) = w; }
                    if (fr >= 14) {
                        if (samp) { if (m & 1) { const int b = (rowi - E_MP) >> 5; *(f32x4*)(cs + ((size_t)b * 2 + (fr - 14)) * E_DFF + j0) = g; } }
                        else if (m == 3) { *(f32x4*)(tail + ((size_t)(grow0 >> 6) * 2 + (fr - 14)) * E_DFF + j0) = g;
                            if (((grow0 + 64) & 2047) == 0) *(f32x4*)(cp + ((size_t)(grow0 >> 11) * 2 + (fr - 14)) * E_DFF + j0) = g; } }
                    xm1 = g;
                }
            }
        }
    }
};
struct EpiStoreF32 {
    static constexpr bool PERM = true, AFTER_DRAIN = false;
    float* out;
    __device__ __forceinline__ void operator()(const f32x4 (&acc)[2][2][4][2], const Unit& u, int wr, int wc, int fr, int fq) const {
        const int rbase = u.pm * BM + wr * 64 + fr; const int col = u.pn * 256 + 32 * wc + 8 * fq;
#pragma unroll
        for (int ai = 0; ai < 2; ++ai)
#pragma unroll
            for (int m = 0; m < 4; ++m) { const size_t row = (size_t)(rbase + ai * HALF + m * 16);
#pragma unroll
                for (int bj = 0; bj < 2; ++bj) { const size_t o = row * 1024 + col + 128 * bj; *(f32x4*)(out + o) = acc[ai][bj][m][0]; *(f32x4*)(out + o + 4) = acc[ai][bj][m][1]; } }
    }
};
struct EpiFinalY {
    static constexpr bool PERM = true, AFTER_DRAIN = false;
    const float* ss; const float* tpe; float* y; PG8_LAS float* tab;
    __device__ __forceinline__ void operator()(const f32x4 (&acc)[2][2][4][2], const Unit& u, int wr, int wc, int fr, int fq) const {
        rstd_table(tab, ss, u.pm);
        const int rbase = u.pm * BM + wr * 64 + fr; const int col = u.pn * 256 + 32 * wc + 8 * fq;
#pragma unroll
        for (int ai = 0; ai < 2; ++ai)
#pragma unroll
            for (int m = 0; m < 4; ++m) { const size_t row = (size_t)(rbase + ai * HALF + m * 16); const float rs = tab[ai * HALF + wr * 64 + m * 16 + fr];
#pragma unroll
                for (int bj = 0; bj < 2; ++bj) { const size_t o = row * 1024 + col + 128 * bj;
                    const f32x4 s0 = fsig4(acc[ai][bj][m][0] * rs), s1 = fsig4(acc[ai][bj][m][1] * rs);
                    *(f32x4*)(y + o) = *(const f32x4*)(y + o) + *(const f32x4*)(tpe + o) * s0; *(f32x4*)(y + o + 4) = *(const f32x4*)(y + o + 4) + *(const f32x4*)(tpe + o + 4) * s1; }
                asm volatile("" ::: "memory"); }
    }
};
template <class Epi, class Sched, bool ALIGN_EPI = false, bool SP2 = false>
__device__ __forceinline__ void gemm_phase(PG8_LAS unsigned char* lds, const Gemm g, const Sched& S, const Epi& E) {
    const int tid = threadIdx.x, wid = __builtin_amdgcn_readfirstlane(tid >> 6), lane = tid & 63, wr = wid >> 2, wc = wid & 3, fr = lane & 15, fq = lane >> 4;
    const int K = g.K, nt = K / BK;
    unsigned voffA[2], voffB[2];
#pragma unroll
    for (int i = 0; i < 2; ++i) { int R, C; stage_rc(tid * 16 + i * 8192, R, C); const int Rb = Epi::PERM ? ((R & ~31) + perm32(R & 31)) : R;
        voffA[i] = (unsigned)(R * K + C) * 2u; voffB[i] = (unsigned)(Rb * K + C) * 2u; }
    const size_t kstep = (size_t)(BK * 2);
    const size_t hstep = (size_t)HALF * K * 2;
    const size_t tstep = 2 * hstep;
    const unsigned ldsw = (unsigned)wid * 1024u;
    const int aoff = lds_byte(wr * 64 + fr, fq * 8), boff = lds_byte(wc * 32 + fr, fq * 8);
#define PG8_SA(b, h) (((b) * 2 + (h)) * HTB)
#define PG8_SB(b, h) ((4 + (b) * 2 + (h)) * HTB)
#define PG8_STAGE(bufoff, gbase, voff) do { _Pragma("unroll") for (int _i = 0; _i < 2; ++_i) \
        __builtin_amdgcn_global_load_lds((const unsigned*)((const char*)(gbase) + (voff)[_i]), (PG8_LAS unsigned*)(lds + (bufoff) + ldsw + _i * 8192), 16, 0, 0); } while (0)
#define PG8_LDA(dst, b, h) do { _Pragma("unroll") for (int m = 0; m < 4; ++m) _Pragma("unroll") for (int k = 0; k < 2; ++k) dst[m][k] = *(const PG8_LAS bf16x8*)(lds + PG8_SA(b, h) + aoff + m * 2048 + k * 1024); } while (0)
#define PG8_LDB(dst, b, h) do { _Pragma("unroll") for (int n = 0; n < 2; ++n) _Pragma("unroll") for (int k = 0; k < 2; ++k) dst[n][k] = *(const PG8_LAS bf16x8*)(lds + PG8_SB(b, h) + boff + n * 2048 + k * 1024); } while (0)
#define PG8_MMA(ai, bj, At, Bt) do { __builtin_amdgcn_s_setprio(1); _Pragma("unroll") for (int m = 0; m < 4; ++m) _Pragma("unroll") for (int n = 0; n < 2; ++n) _Pragma("unroll") for (int k = 0; k < 2; ++k) \
        acc[ai][bj][m][n] = __builtin_amdgcn_mfma_f32_16x16x32_bf16(Bt[n][k], At[m][k], acc[ai][bj][m][n], 0, 0, 0); __builtin_amdgcn_s_setprio(0); } while (0)
#define PG8_WAIT_V(n) asm volatile("s_waitcnt vmcnt(" #n ")" ::: "memory")
#define PG8_WAIT_L(n) asm volatile("s_waitcnt lgkmcnt(" #n ")" ::: "memory")
#define PG8_BAR __builtin_amdgcn_s_barrier()
#define PG8_SCHED __builtin_amdgcn_sched_barrier(0)
    Unit cur, nxt; int ui = 0;
    if (!S.next(0, cur)) return;
    f32x4 acc[2][2][4][2];
#pragma unroll
    for (int a = 0; a < 2; ++a)
#pragma unroll
        for (int b = 0; b < 2; ++b)
#pragma unroll
            for (int m = 0; m < 4; ++m)
#pragma unroll
                for (int n = 0; n < 2; ++n) acc[a][b][m][n] = (f32x4){0.f, 0.f, 0.f, 0.f};
    bf16x8 At[4][2], B0[2][2], B1[2][2];
    const char* cA = (const char*)g.A + (size_t)cur.pm * tstep; const char* cB = (const char*)g.Bt + (size_t)cur.pn * tstep;
    S.a_ready(cur);
    if constexpr (SP2) {
        PG8_STAGE(PG8_SB(0, 0), cB, voffB); PG8_STAGE(PG8_SB(0, 1), cB + hstep, voffB); PG8_STAGE(PG8_SA(0, 0), cA, voffA); PG8_STAGE(PG8_SA(0, 1), cA + hstep, voffA);
        if (wr == 1) PG8_BAR;
        PG8_WAIT_V(2); PG8_BAR;
        PG8_STAGE(PG8_SB(1, 0), cB + kstep, voffB); PG8_STAGE(PG8_SA(1, 0), cA + kstep, voffA); PG8_STAGE(PG8_SB(1, 1), cB + hstep + kstep, voffB);
        PG8_WAIT_V(6); PG8_BAR;
    } else {
        PG8_STAGE(PG8_SB(0, 0), cB, voffB); PG8_STAGE(PG8_SA(0, 0), cA, voffA); PG8_STAGE(PG8_SB(0, 1), cB + hstep, voffB); PG8_STAGE(PG8_SA(0, 1), cA + hstep, voffA);
        if (wr == 1) PG8_BAR;
        PG8_WAIT_V(4); PG8_BAR;
        PG8_STAGE(PG8_SB(1, 0), cB + kstep, voffB); PG8_STAGE(PG8_SA(1, 0), cA + kstep, voffA); PG8_STAGE(PG8_SB(1, 1), cB + hstep + kstep, voffB);
        PG8_WAIT_V(6); PG8_BAR;
    }
    for (;;) {
        const bool has_next = S.next(ui + 1, nxt);
        const char* nA = has_next ? (const char*)g.A + (size_t)nxt.pm * tstep : cA; const char* nB = has_next ? (const char*)g.Bt + (size_t)nxt.pn * tstep : cB;
        for (int t = 0; t < nt; t += 2) {
            const bool last = (t == nt - 2);
            const char* a1 = cA + (size_t)(t + 1) * kstep;
            const char* a2 = last ? nA : cA + (size_t)(t + 2) * kstep; const char* b2 = last ? nB : cB + (size_t)(t + 2) * kstep;
            const char* a3 = a2 + kstep; const char* b3 = b2 + kstep;
            if (last && has_next) S.a_ready(nxt);
            if constexpr (SP2) {
            PG8_LDB(B0, 0, 0); PG8_LDB(B1, 0, 1); PG8_SCHED; PG8_LDA(At, 0, 0); PG8_STAGE(PG8_SA(1, 1), a1 + hstep, voffA);
            PG8_WAIT_V(8); PG8_WAIT_L(0); PG8_BAR; PG8_MMA(0, 0, At, B0); PG8_MMA(0, 1, At, B1); PG8_BAR; PG8_SCHED;
            PG8_LDA(At, 0, 1); PG8_STAGE(PG8_SB(0, 0), b2, voffB); PG8_STAGE(PG8_SB(0, 1), b2 + hstep, voffB); PG8_STAGE(PG8_SA(0, 0), a2, voffA);
            PG8_WAIT_V(8); PG8_WAIT_L(0); PG8_BAR; PG8_MMA(1, 0, At, B0); PG8_MMA(1, 1, At, B1); PG8_BAR; PG8_SCHED;
            PG8_LDB(B0, 1, 0); PG8_LDB(B1, 1, 1); PG8_SCHED; PG8_LDA(At, 1, 0); PG8_STAGE(PG8_SA(0, 1), a2 + hstep, voffA);
            PG8_WAIT_V(8); PG8_WAIT_L(0); PG8_BAR; PG8_MMA(0, 0, At, B0); PG8_MMA(0, 1, At, B1); PG8_BAR; PG8_SCHED;
            PG8_LDA(At, 1, 1); PG8_STAGE(PG8_SB(1, 0), b3, voffB); PG8_STAGE(PG8_SB(1, 1), b3 + hstep, voffB); PG8_STAGE(PG8_SA(1, 0), a3, voffA);
            PG8_WAIT_V(8); PG8_WAIT_L(0); PG8_BAR; PG8_MMA(1, 0, At, B0); PG8_MMA(1, 1, At, B1); PG8_BAR; PG8_SCHED;
            } else {
            PG8_LDB(B0, 0, 0); PG8_SCHED; PG8_LDA(At, 0, 0); PG8_STAGE(PG8_SA(1, 1), a1 + hstep, voffA);
            PG8_WAIT_L(8); PG8_BAR; PG8_WAIT_L(0); PG8_MMA(0, 0, At, B0); PG8_BAR; PG8_SCHED;
            PG8_LDB(B1, 0, 1); PG8_STAGE(PG8_SB(0, 0), b2, voffB);
            PG8_BAR; PG8_WAIT_L(0); PG8_MMA(0, 1, At, B1); PG8_BAR;
            PG8_LDA(At, 0, 1); PG8_STAGE(PG8_SA(0, 0), a2, voffA);
            PG8_BAR; PG8_WAIT_L(0); PG8_MMA(1, 0, At, B0); PG8_BAR; PG8_SCHED;
            PG8_STAGE(PG8_SB(0, 1), b2 + hstep, voffB);
            PG8_WAIT_V(6); PG8_BAR; PG8_MMA(1, 1, At, B1); PG8_BAR;
            PG8_LDB(B0, 1, 0); PG8_SCHED; PG8_LDA(At, 1, 0); PG8_STAGE(PG8_SA(0, 1), a2 + hstep, voffA);
            PG8_WAIT_L(8); PG8_BAR; PG8_WAIT_L(0); PG8_MMA(0, 0, At, B0); PG8_BAR; PG8_SCHED;
            PG8_LDB(B1, 1, 1); PG8_STAGE(PG8_SB(1, 0), b3, voffB);
            PG8_BAR; PG8_WAIT_L(0); PG8_MMA(0, 1, At, B1); PG8_BAR;
            PG8_LDA(At, 1, 1); PG8_STAGE(PG8_SA(1, 0), a3, voffA);
            PG8_BAR; PG8_WAIT_L(0); PG8_MMA(1, 0, At, B0); PG8_BAR; PG8_SCHED;
            PG8_STAGE(PG8_SB(1, 1), b3 + hstep, voffB);
            PG8_WAIT_V(6); PG8_BAR; PG8_MMA(1, 1, At, B1); PG8_BAR;
            }
        }
        if constexpr (ALIGN_EPI) { if (wr == 0) PG8_BAR; }
        if constexpr (!Epi::AFTER_DRAIN) { E(acc, cur, wr, wc, fr, fq); S.done(cur); }
        if (!has_next) break;
#pragma unroll
        for (int a = 0; a < 2; ++a)
#pragma unroll
            for (int b = 0; b < 2; ++b)
#pragma unroll
                for (int m = 0; m < 4; ++m)
#pragma unroll
                    for (int n = 0; n < 2; ++n) acc[a][b][m][n] = (f32x4){0.f, 0.f, 0.f, 0.f};
        cur = nxt; cA = nA; cB = nB; ++ui;
        if constexpr (ALIGN_EPI) { if (wr == 1) PG8_BAR; }
    }
    PG8_WAIT_V(0);
    if constexpr (!ALIGN_EPI) { if (wr == 0) PG8_BAR; }
    PG8_BAR;
    if constexpr (Epi::AFTER_DRAIN) { E.fused(acc, cur, wr, wc, fr, fq, lds, wid, lane); S.done(cur); }
#undef PG8_SA
#undef PG8_SB
#undef PG8_STAGE
#undef PG8_LDA
#undef PG8_LDB
#undef PG8_MMA
#undef PG8_WAIT_V
#undef PG8_WAIT_L
#undef PG8_BAR
#undef PG8_SCHED
}
}

constexpr int NWAVES = 8;
constexpr int RING_BYTES = 131072, LDSCTL_OFF = RING_BYTES, MISC_OFF = LDSCTL_OFF + 320, LDS_BYTES = 147456;
constexpr size_t al256(size_t x) { return (x + 255) & ~(size_t)255; }
constexpr size_t WS_CTL = 0, CTL_ZERO_BYTES = 1u << 20;
constexpr size_t WS_BT_IN = CTL_ZERO_BYTES;
constexpr size_t WS_BT_BD = WS_BT_IN + (size_t)DIN * D * 2;
constexpr size_t WS_BT_BR = WS_BT_BD + (size_t)D * 512 * 2;
constexpr size_t WS_BT_O = WS_BT_BR + (size_t)D * 512 * 2;
constexpr size_t WS_BT_GU = WS_BT_O + (size_t)D * D * 2;
constexpr size_t WS_BT_D = WS_BT_GU + (size_t)DIN * D * 2;
constexpr size_t WS_BT_PE = WS_BT_D + (size_t)D * DFF * 2;
constexpr size_t WS_BT_PG = WS_BT_PE + (size_t)D * PE * 2;
constexpr size_t WS_ROT = WS_BT_PG + (size_t)D * D * 2;
constexpr size_t WS_XN = al256(WS_ROT + (size_t)2080 * 64 * 8);
constexpr size_t WS_PEB = WS_XN + (size_t)M * D * 2;
constexpr size_t WS_REGB = WS_PEB + (size_t)M * PE * 2;
constexpr size_t WS_OD = WS_REGB + (size_t)M * DIN * 2;
constexpr size_t WS_OR = WS_OD + (size_t)M * 512 * 2;
constexpr size_t WS_H1 = WS_OR + (size_t)M * 512 * 2;
constexpr size_t WS_REGA = WS_H1 + (size_t)M * D * 4;
constexpr size_t WS_END = WS_REGA + (size_t)M * DIN * 2;

#define GAS __attribute__((address_space(1)))
#define LAS __attribute__((address_space(3)))
typedef unsigned v4u __attribute__((ext_vector_type(4)));
typedef GAS unsigned gu32;
#define RLX_AGENT __ATOMIC_RELAXED, __HIP_MEMORY_SCOPE_AGENT
#define LDS_WAIT() asm volatile("s_waitcnt lgkmcnt(0)" ::: "memory")
#define VM_WAIT() asm volatile("s_waitcnt vmcnt(0)" ::: "memory")
__device__ __forceinline__ unsigned pk2(float lo, float hi) { return (unsigned)f2bf(lo) | ((unsigned)f2bf(hi) << 16); }

struct Args { const float* in[31]; float* out; unsigned char* ws; int ph_lo, ph_hi; };

__device__ __forceinline__ void p0_transpose_item(const float* W, int K, int N, bf16_t* WT, int dst_row0, const float* gk, LAS float* scr, int k0, int n0, int lane) {
#pragma unroll 8
    for (int i = 0; i < 32; ++i) { const int kk = 2 * i + (lane >> 5); float w = W[(size_t)(k0 + kk) * N + n0 + (lane & 31)]; if (gk) w *= gk[k0 + kk]; scr[kk * 33 + (lane & 31)] = w; }
    LDS_WAIT(); asm volatile("" ::: "memory");
    const int c = lane & 7;
#pragma unroll
    for (int j = 0; j < 4; ++j) { const int n = (lane >> 3) + 8 * j; const LAS float* s = scr + (8 * c) * 33 + n;
        v4u o; o.x = pk2(s[0 * 33], s[1 * 33]); o.y = pk2(s[2 * 33], s[3 * 33]); o.z = pk2(s[4 * 33], s[5 * 33]); o.w = pk2(s[6 * 33], s[7 * 33]);
        *(v4u*)(WT + (size_t)(dst_row0 + n) * K + k0 + 8 * c) = o; }
    LDS_WAIT(); asm volatile("" ::: "memory");
}
__device__ __forceinline__ int btin_dst(int nb) {
    const int tile = nb >> 3, o = nb & 7; int ct;
    if (tile < 4) ct = 128 * (o & 1) + 32 * (o >> 1);
    else if (tile >= 6 && tile < 10) ct = 128 * ((o >> 1) & 1) + 32 * (2 * (o >> 2) + (o & 1));
    else ct = 32 * o;
    return tile * 256 + ct;
}
__device__ __forceinline__ float wave_sum(float v) {
#pragma unroll
    for (int o = 1; o < 64; o <<= 1) v += __shfl_xor(v, o);
    return v;
}

__global__ void __launch_bounds__(NWAVES * 64, 2) mk_fwd(Args args) {
    extern __shared__ __attribute__((aligned(16))) unsigned char lds[];
    LAS unsigned char* L = (LAS unsigned char*)lds;
    const int tid = threadIdx.x, lane = tid & 63, wave = __builtin_amdgcn_readfirstlane(tid >> 6);
    const int G = gridDim.x, bx = blockIdx.x; const int vcu = (G % 8 == 0) ? (bx % 8) * (G / 8) + bx / 8 : bx;
    unsigned char* ws = args.ws;
    const int lo = args.ph_lo, hi = args.ph_hi;
#define IN(k) (lo <= (k) && (k) < hi)
    const float* x_p = args.in[0]; const float* x_s = args.in[1]; const float* p_p = args.in[2]; const float* p_s = args.in[3];
    bf16_t* XN = (bf16_t*)(ws + WS_XN); bf16_t* PEB = (bf16_t*)(ws + WS_PEB); float* ROT = (float*)(ws + WS_ROT);
    bf16_t* QD = (bf16_t*)(ws + WS_REGB); bf16_t* KD = QD + (size_t)M * 512; bf16_t* VD = KD + (size_t)M * 512; bf16_t* QR = VD + (size_t)M * 512; bf16_t* KR = QR + (size_t)M * 512;
    bf16_t* VR = KR + (size_t)M * 512; bf16_t* GRS = VR + (size_t)M * 512; bf16_t* GD = GRS + (size_t)M * 512; bf16_t* GT = GD + (size_t)M * D;
    float* out = args.out;
    float* k_p = out + (size_t)M * D; float* v_p = k_p + (size_t)MP * 512; float* r_p = v_p + (size_t)MP * 512; float* c_p = r_p + (size_t)16 * 4 * 128 * 128;
    float* k_s = c_p + (size_t)16 * 2 * DFF; float* v_s = k_s + (size_t)MS * 512;

    if (IN(0)) {
        LAS float* scr = (LAS float*)(L + wave * 16384);
        const int gw = vcu * NWAVES + wave, NGW = G * NWAVES;
        const float* w_in = args.in[10]; const float* w_bd = args.in[19]; const float* w_br = args.in[20]; const float* w_o = args.in[21]; const float* g_ffn = args.in[22];
        const float* w_g = args.in[23]; const float* w_u = args.in[24]; const float* w_d = args.in[27]; const float* g_pe = args.in[28]; const float* w_pe = args.in[29]; const float* w_pg = args.in[30];
        constexpr int I_IN = 16 * 176, I_BD = 8 * 32, I_O = 16 * 32, I_G = 16 * 88, I_D = 44 * 32, I_PE = 4 * 32;
        constexpr int NITEMS = I_IN + 2 * I_BD + I_O + 2 * I_G + I_D + I_PE + I_O;
        for (int it = gw; it < NITEMS; it += NGW) {
            int r = it;
            if (r < I_IN) { const int kb = r / 176, nb = r % 176; p0_transpose_item(w_in, D, DIN, (bf16_t*)(ws + WS_BT_IN), btin_dst(nb), nullptr, scr, 64 * kb, 32 * nb, lane); continue; } r -= I_IN;
            if (r < I_BD) { const int kb = r / 32, nb = r % 32; p0_transpose_item(w_bd, 512, D, (bf16_t*)(ws + WS_BT_BD), 32 * nb, nullptr, scr, 64 * kb, 32 * nb, lane); continue; } r -= I_BD;
            if (r < I_BD) { const int kb = r / 32, nb = r % 32; p0_transpose_item(w_br, 512, D, (bf16_t*)(ws + WS_BT_BR), 32 * nb, nullptr, scr, 64 * kb, 32 * nb, lane); continue; } r -= I_BD;
            if (r < I_O) { const int kb = r / 32, nb = r % 32; p0_transpose_item(w_o, D, D, (bf16_t*)(ws + WS_BT_O), 32 * nb, nullptr, scr, 64 * kb, 32 * nb, lane); continue; } r -= I_O;
            if (r < I_G) { const int kb = r / 88, nb = r % 88; p0_transpose_item(w_g, D, DFF, (bf16_t*)(ws + WS_BT_GU), 256 * (nb >> 2) + 32 * (nb & 3), g_ffn, scr, 64 * kb, 32 * nb, lane); continue; } r -= I_G;
            if (r < I_G) { const int kb = r / 88, nb = r % 88; p0_transpose_item(w_u, D, DFF, (bf16_t*)(ws + WS_BT_GU), 256 * (nb >> 2) + 128 + 32 * (nb & 3), g_ffn, scr, 64 * kb, 32 * nb, lane); continue; } r -= I_G;
            if (r < I_D) { const int kb = r / 32, nb = r % 32; p0_transpose_item(w_d, DFF, D, (bf16_t*)(ws + WS_BT_D), 32 * nb, nullptr, scr, 64 * kb, 32 * nb, lane); continue; } r -= I_D;
            if (r < I_PE) { const int kb = r / 32, nb = r % 32; p0_transpose_item(w_pe, PE, D, (bf16_t*)(ws + WS_BT_PE), 32 * nb, nullptr, scr, 64 * kb, 32 * nb, lane); continue; } r -= I_PE;
            { const int kb = r / 32, nb = r % 32; p0_transpose_item(w_pg, D, D, (bf16_t*)(ws + WS_BT_PG), 32 * nb, g_pe, scr, 64 * kb, 32 * nb, lane); }
        }
        const float* g_mix = args.in[9];
        for (int m = gw; m < M; m += NGW) {
            const float* xr = m < MP ? x_p + (size_t)m * D : x_s + (size_t)(m - MP) * D;
            f32x4 v[4]; float ss = 0.f;
#pragma unroll
            for (int j = 0; j < 4; ++j) { v[j] = ((const f32x4*)xr)[lane + 64 * j]; ss += (v[j][0] * v[j][0] + v[j][1] * v[j][1]) + (v[j][2] * v[j][2] + v[j][3] * v[j][3]); }
            const float rstd = rsqrtf(wave_sum(ss) * (1.f / D) + EPS);
#pragma unroll
            for (int j = 0; j < 4; ++j) { const f32x4 gv = ((const f32x4*)g_mix)[lane + 64 * j]; const f32x4 o = v[j] * rstd * gv;
                uint2 w; w.x = pk2(o[0], o[1]); w.y = pk2(o[2], o[3]); ((uint2*)(XN + (size_t)m * D))[lane + 64 * j] = w; }
        }
        for (size_t i = (size_t)gw * 64 + lane; i < (size_t)M * PE / 4; i += (size_t)NGW * 64) {
            const f32x4 v = i < (size_t)MP * PE / 4 ? ((const f32x4*)p_p)[i] : ((const f32x4*)p_s)[i - (size_t)MP * PE / 4];
            uint2 w; w.x = pk2(v[0], v[1]); w.y = pk2(v[2], v[3]); ((uint2*)PEB)[i] = w; }
        for (int i = gw * 64 + lane; i < 2080 * 64; i += NGW * 64) { const int pidx = i >> 6, d = i & 63; const int pos = pidx < 2048 ? pidx : PAST + (pidx - 2048);
            const float inv = powf(10000.f, -(float)d / 64.f); const float ang = (float)pos * inv; float sn, cs; sincosf(ang, &sn, &cs); ROT[2 * i] = cs; ROT[2 * i + 1] = sn; }
    }
    if (IN(1)) {
        pg8::Gemm g{XN, (const bf16_t*)(ws + WS_BT_IN), M, DIN, D}; pg8::StaticOrder S; S.init(M, DIN, G, bx);
        pg8::EpiIn E{QD, KD, VD, QR, KR, VR, GRS, GD, GT, k_p, k_s, v_p, v_s, args.in[11], args.in[12], ROT};
        pg8::gemm_phase<pg8::EpiIn, pg8::StaticOrder, true, true>(L, g, S, E);
    }
    bf16_t* OD = (bf16_t*)(ws + WS_OD); bf16_t* ORb = (bf16_t*)(ws + WS_OR);
    float* T1 = (float*)(ws + WS_REGB); bf16_t* MIX = (bf16_t*)(ws + WS_REGB + (size_t)M * D * 4);
    bf16_t* ACT = (bf16_t*)(ws + WS_REGB); float* HEADP = (float*)(ws + WS_REGB + (size_t)200 * 1048576); float* HEADU = HEADP + (size_t)512 * 2 * DFF; float* TAIL = HEADU + (size_t)512 * 2 * DFF;
    float* H1 = (float*)(ws + WS_H1); float* TPE = H1; float* SS1 = (float*)(ws + WS_OD); float* SS2 = SS1 + (size_t)1048576;
    float* y = out; float* c_s = v_s + (size_t)MS * 512 + (size_t)32 * 4 * 128 * 128;
    LAS float* tab = (LAS float*)(L + LDSCTL_OFF + 1024);
    if (IN(3)) {
        { pg8::Gemm g{OD, (const bf16_t*)(ws + WS_BT_BD), M, D, 512}; pg8::StaticOrder S; S.init(M, D, G, bx); pg8::EpiGateT1 E{GD, T1};
          pg8::gemm_phase<pg8::EpiGateT1, pg8::StaticOrder, true, true>(L, g, S, E); }
        { pg8::Gemm g{ORb, (const bf16_t*)(ws + WS_BT_BR), M, D, 512}; pg8::StaticOrder S; S.init(M, D, G, bx); pg8::EpiMixOut E{GT, T1, MIX};
          pg8::gemm_phase<pg8::EpiMixOut, pg8::StaticOrder, true, true>(L, g, S, E); }
    }
    if (IN(4)) {
        pg8::Gemm g{MIX, (const bf16_t*)(ws + WS_BT_O), M, D, D}; pg8::StaticOrder S; S.init(M, D, G, bx);
        pg8::EpiResNorm E{x_p, x_s, H1, XN, SS1};
        pg8::gemm_phase<pg8::EpiResNorm, pg8::StaticOrder, true, true>(L, g, S, E);
    }
    if (IN(5)) {
        pg8::Gemm g{XN, (const bf16_t*)(ws + WS_BT_GU), M, DIN, D}; pg8::StaticOrder S; S.init(M, DIN, G, bx);
        pg8::EpiGU E{SS1, args.in[7], args.in[25], args.in[26], ACT, HEADP, HEADU, TAIL, c_p, c_s, tab};
        pg8::gemm_phase<pg8::EpiGU, pg8::StaticOrder, true, true>(L, g, S, E);
    }
    if (IN(6)) {
        const float* cw = args.in[25];
        for (int i = bx * (NWAVES * 64) + tid; i < 512 * 2 * (DFF / 4); i += G * NWAVES * 64) {
            const int j4 = i % (DFF / 4), rr = (i / (DFF / 4)) & 1, grp = i / (2 * (DFF / 4));
            const size_t o = ((size_t)grp * 2 + rr) * DFF + 4 * j4;
            f32x4 gc = *(const f32x4*)(HEADP + o); const f32x4 uu = *(const f32x4*)(HEADU + o);
            if (grp & 31) { const f32x4 t0 = *(const f32x4*)(TAIL + ((size_t)(grp - 1) * 2) * DFF + 4 * j4), t1 = *(const f32x4*)(TAIL + ((size_t)(grp - 1) * 2 + 1) * DFF + 4 * j4);
                const f32x4 w0 = *(const f32x4*)(cw + 4 * j4), w1 = *(const f32x4*)(cw + DFF + 4 * j4);
                gc = rr == 0 ? gc + w0 * t0 + w1 * t1 : gc + w0 * t1; }
            f32x4 a;
#pragma unroll
            for (int k = 0; k < 4; ++k) a[k] = pg8::gelu_t(gc[k]) * uu[k];
            uint2 w; w.x = pg8::cvtpk(a[0], a[1]); w.y = pg8::cvtpk(a[2], a[3]);
            *(uint2*)(ACT + (size_t)(grp * 64 + rr) * DFF + 4 * j4) = w;
        }
    }
    if (IN(7)) {
        pg8::Gemm g{ACT, (const bf16_t*)(ws + WS_BT_D), M, D, DFF}; pg8::StaticOrder S; S.init(M, D, G, bx);
        pg8::EpiResNorm E{H1, H1 + (size_t)MP * D, y, XN, SS2};
        pg8::gemm_phase<pg8::EpiResNorm, pg8::StaticOrder, true, true>(L, g, S, E);
    }
    if (IN(8)) {
        { int kpe = PE; asm volatile("" : "+s"(kpe));
          pg8::Gemm g{PEB, (const bf16_t*)(ws + WS_BT_PE), M, D, kpe}; pg8::StaticOrder S; S.init(M, D, G, bx); pg8::EpiStoreF32 E{TPE};
          pg8::gemm_phase<pg8::EpiStoreF32, pg8::StaticOrder, true, true>(L, g, S, E); }
        { pg8::Gemm g{XN, (const bf16_t*)(ws + WS_BT_PG), M, D, D}; pg8::StaticOrder S; S.init(M, D, G, bx); pg8::EpiFinalY E{SS2, TPE, y, tab};
          pg8::gemm_phase<pg8::EpiFinalY, pg8::StaticOrder, true, true>(L, g, S, E); }
    }
#undef IN
}
extern "C" void kernel_launch(void* const* d_in, const int* in_sizes, int n_in, void* d_out, int out_size, void* d_ws, size_t ws_size, hipStream_t stream) {
    const float* x_p = (const float*)d_in[0]; const float* x_s = (const float*)d_in[1];
    const float* cache_k = (const float*)d_in[4]; const float* cache_v = (const float*)d_in[5]; const float* state_ret = (const float*)d_in[6]; const float* state_conv = (const float*)d_in[7];
    const float* rel_bias = (const float*)d_in[8];
    const float* lq1 = (const float*)d_in[13]; const float* lk1 = (const float*)d_in[14]; const float* lq2 = (const float*)d_in[15];
    const float* lk2 = (const float*)d_in[16]; const float* g_da = (const float*)d_in[17]; const float* g_rt = (const float*)d_in[18]; const float* w_bd = (const float*)d_in[19];
    const float* w_br = (const float*)d_in[20]; const float* w_o = (const float*)d_in[21]; const float* g_ffn = (const float*)d_in[22]; const float* w_g = (const float*)d_in[23];
    const float* w_u = (const float*)d_in[24]; const float* conv_w = (const float*)d_in[25]; const float* conv_b = (const float*)d_in[26]; const float* w_d = (const float*)d_in[27];
    const float* g_pe = (const float*)d_in[28]; const float* w_pe = (const float*)d_in[29]; const float* w_pg = (const float*)d_in[30];
    float* out = (float*)d_out;
    float* y = out; float* k_p = out + (size_t)M * D; float* v_p = k_p + (size_t)MP * 512; float* r_p = v_p + (size_t)MP * 512; float* c_p = r_p + (size_t)16 * 4 * 128 * 128;
    float* k_s = c_p + (size_t)16 * 2 * DFF; float* v_s = k_s + (size_t)MS * 512; float* r_s = v_s + (size_t)MS * 512; float* c_s = r_s + (size_t)32 * 4 * 128 * 128;
    (void)k_p; (void)k_s; (void)v_p; (void)v_s;
    static int grid = 0;
    if (grid == 0) {
        if (ws_size < WS_END) { fprintf(stderr, "kernel_launch: workspace too small: need %zu have %zu\n", (size_t)WS_END, ws_size); grid = -1; return; }
        int dev = 0, cus = 0; hipGetDevice(&dev); hipDeviceGetAttribute(&cus, hipDeviceAttributeMultiprocessorCount, dev);
        if (hipFuncSetAttribute((const void*)mk_fwd, hipFuncAttributeMaxDynamicSharedMemorySize, LDS_BYTES) != hipSuccess) { fprintf(stderr, "kernel_launch: hipFuncSetAttribute failed\n"); grid = -1; return; }
        grid = cus;
    }
    if (grid < 0) return;
    unsigned char* ws = (unsigned char*)d_ws;
    hipMemsetAsync(ws + WS_CTL, 0, CTL_ZERO_BYTES, stream);
    Args a; memset(&a, 0, sizeof(a));
    for (int i = 0; i < 31; ++i) a.in[i] = (const float*)d_in[i];
    a.out = out; a.ws = ws;
    a.ph_lo = 0; a.ph_hi = 1; hipLaunchKernelGGL(mk_fwd, dim3(grid), dim3(NWAVES * 64), LDS_BYTES, stream, a);
    a.ph_lo = 1; a.ph_hi = 2; hipLaunchKernelGGL(mk_fwd, dim3(grid), dim3(NWAVES * 64), LDS_BYTES, stream, a);

    bf16_t* XN = (bf16_t*)(ws + WS_XN); bf16_t* PEB = (bf16_t*)(ws + WS_PEB);
    bf16_t* QD = (bf16_t*)(ws + WS_REGB); bf16_t* KD = QD + (size_t)M * 512; bf16_t* VD = KD + (size_t)M * 512; bf16_t* QR = VD + (size_t)M * 512; bf16_t* KR = QR + (size_t)M * 512;
    bf16_t* VR = KR + (size_t)M * 512; bf16_t* GRS = VR + (size_t)M * 512; bf16_t* GD = GRS + (size_t)M * 512; bf16_t* GT = GD + (size_t)M * D;
    bf16_t* OD = (bf16_t*)(ws + WS_OD); bf16_t* ORb = (bf16_t*)(ws + WS_OR); float* H1 = (float*)(ws + WS_H1);
    unsigned char* regA = ws + WS_REGA; unsigned char* regB = ws + WS_REGB;
    float* T1 = (float*)regA; bf16_t* MIX = (bf16_t*)(regA + (size_t)M * D * 4);
    bf16_t* G = (bf16_t*)regA; bf16_t* U = G + (size_t)M * DFF;
    bf16_t* ACT = (bf16_t*)regB; float* TPE = (float*)(regB + (size_t)M * DFF * 2);
    const dim3 blk(256);
    { AttnP p{QD, KD, VD, cache_k, cache_v, rel_bias, lq1, lk1, lq2, lk2, g_da, OD}; k_attn<<<16 * 4 * 64 + 32 * 4, blk, 0, stream>>>(p); }
    { RetP p{QR, KR, VR, GRS, state_ret, g_rt, ORb, r_p, r_s}; k_ret<<<64 + 128, blk, 0, stream>>>(p); }
    for (int ph = 3; ph <= 8; ++ph) { a.ph_lo = ph; a.ph_hi = ph + 1; hipLaunchKernelGGL(mk_fwd, dim3(grid), dim3(NWAVES * 64), LDS_BYTES, stream, a); }
}
```

```cpp
#include <hip/hip_runtime.h>
#include <stdint.h>
#include <cstdio>

typedef unsigned short bf16_t;
typedef short bf16x8 __attribute__((ext_vector_type(8)));
typedef float f32x4 __attribute__((ext_vector_type(4)));

constexpr int D = 1024, MP = 32768, MS = 1024, M = MP + MS, TP = 2048, TS = 32, PAST = 4096;
constexpr int DIN = 5632, DFF = 2816, PE = 256;
constexpr float EPS = 1e-6f;
constexpr float LAM_INIT = 0.2f;

__device__ __forceinline__ unsigned short f2bf(float f) { unsigned u = __float_as_uint(f); return (unsigned short)((u + 0x7fffu + ((u >> 16) & 1u)) >> 16); }
__device__ __forceinline__ float bf2f(unsigned short b) { return __uint_as_float(((unsigned)b) << 16); }
__device__ __forceinline__ float sigmoidf_(float x) { return 1.f / (1.f + __expf(-x)); }
__device__ __forceinline__ float gelu_tanh(float x) { const float u = 0.7978845608028654f * (x + 0.044715f * x * x * x); return 0.5f * x * (1.f + tanhf(u)); }
__device__ __forceinline__ void row_info(int m, int& b, int& t, int& pos) {
    if (m < MP) { b = m >> 11; t = m & 2047; pos = t; } else { const int ms = m - MP; b = ms >> 5; t = ms & 31; pos = PAST + t; }
}
__device__ __forceinline__ int t5_bucket(int rel) {
    const int ret = rel > 0 ? 16 : 0; const int n = rel < 0 ? -rel : rel;
    int v;
    if (n < 8) v = n; else if (n < 12) v = 8; else if (n < 16) v = 9; else if (n < 23) v = 10; else if (n < 32) v = 11; else if (n < 46) v = 12; else if (n < 64) v = 13; else if (n < 91) v = 14; else v = 15;
    return ret + v;
}

__global__ void __launch_bounds__(256) k_rmsnorm(const float* __restrict__ xp, const float* __restrict__ xs, const float* __restrict__ g, bf16_t* __restrict__ out) {
    const int row = (blockIdx.x * 256 + threadIdx.x) >> 6, lane = threadIdx.x & 63;
    if (row >= M) return;
    const float* xr = row < MP ? xp + (size_t)row * D : xs + (size_t)(row - MP) * D;
    float4 v[4]; float ss = 0.f;
#pragma unroll
    for (int j = 0; j < 4; ++j) { v[j] = ((const float4*)xr)[lane + 64 * j]; ss += v[j].x * v[j].x + v[j].y * v[j].y + v[j].z * v[j].z + v[j].w * v[j].w; }
#pragma unroll
    for (int o = 1; o < 64; o <<= 1) ss += __shfl_xor(ss, o);
    const float rstd = rsqrtf(ss * (1.f / D) + EPS);
#pragma unroll
    for (int j = 0; j < 4; ++j) { const float4 gv = ((const float4*)g)[lane + 64 * j];
        ushort4 o; o.x = f2bf(v[j].x * rstd * gv.x); o.y = f2bf(v[j].y * rstd * gv.y); o.z = f2bf(v[j].z * rstd * gv.z); o.w = f2bf(v[j].w * rstd * gv.w);
        ((ushort4*)(out + (size_t)row * D))[lane + 64 * j] = o; }
}
__global__ void __launch_bounds__(256) k_cvt_pe(const float* __restrict__ pp, const float* __restrict__ ps, bf16_t* __restrict__ out) {
    const size_t i = (size_t)blockIdx.x * 256 + threadIdx.x;
    if (i >= (size_t)M * PE / 4) return;
    const size_t e = i * 4; const float4 v = e < (size_t)MP * PE ? ((const float4*)pp)[i] : ((const float4*)ps)[i - (size_t)MP * PE / 4];
    ushort4 o; o.x = f2bf(v.x); o.y = f2bf(v.y); o.z = f2bf(v.z); o.w = f2bf(v.w); ((ushort4*)out)[i] = o;
}

struct GemmArgs { const bf16_t* A; const float* W; int lda, N, K, pad; };
template <class Epi>
__global__ void __launch_bounds__(256) k_gemm(GemmArgs ga, Epi epi) {
    const bf16_t* __restrict__ A = ga.A; const float* __restrict__ W = ga.W; const int lda = ga.lda, N = ga.N, K = ga.K;
    __shared__ __attribute__((aligned(16))) bf16_t As[64][40];
    __shared__ __attribute__((aligned(16))) bf16_t Bs[64][40];
    const int tid = threadIdx.x, lane = tid & 63, w = tid >> 6, fr = lane & 15, fq = lane >> 4;
    const int n0 = blockIdx.x * 64, m0 = blockIdx.y * 64;
    f32x4 acc[4];
#pragma unroll
    for (int i = 0; i < 4; ++i) acc[i] = (f32x4){0.f, 0.f, 0.f, 0.f};
    const int ar = tid >> 2, ac = (tid & 3) * 8;
    const int wk = tid >> 3, wn = (tid & 7) * 8;
    for (int k0 = 0; k0 < K; k0 += 32) {
        const uint4 av = *(const uint4*)(A + (size_t)(m0 + ar) * lda + k0 + ac);
        const float4 w0 = *(const float4*)(W + (size_t)(k0 + wk) * N + n0 + wn), w1 = *(const float4*)(W + (size_t)(k0 + wk) * N + n0 + wn + 4);
        __syncthreads();
        *(uint4*)&As[ar][ac] = av;
        Bs[wn + 0][wk] = f2bf(w0.x); Bs[wn + 1][wk] = f2bf(w0.y); Bs[wn + 2][wk] = f2bf(w0.z); Bs[wn + 3][wk] = f2bf(w0.w);
        Bs[wn + 4][wk] = f2bf(w1.x); Bs[wn + 5][wk] = f2bf(w1.y); Bs[wn + 6][wk] = f2bf(w1.z); Bs[wn + 7][wk] = f2bf(w1.w);
        __syncthreads();
        const bf16x8 a = *(const bf16x8*)&As[16 * w + fr][8 * fq];
#pragma unroll
        for (int nt = 0; nt < 4; ++nt) { const bf16x8 b = *(const bf16x8*)&Bs[16 * nt + fr][8 * fq]; acc[nt] = __builtin_amdgcn_mfma_f32_16x16x32_bf16(a, b, acc[nt], 0, 0, 0); }
    }
#pragma unroll
    for (int nt = 0; nt < 4; ++nt)
#pragma unroll
        for (int j = 0; j < 4; ++j) epi(m0 + 16 * w + fq * 4 + j, n0 + 16 * nt + fr, acc[nt][j]);
}
struct EpiBf16 { bf16_t* out; int ld; int pad; __device__ void operator()(int r, int c, float v) const { out[(size_t)r * ld + c] = f2bf(v); } };
struct EpiF32 { float* out; int ld; int pad; __device__ void operator()(int r, int c, float v) const { out[(size_t)r * ld + c] = v; } };
struct EpiGate { const bf16_t* gate; float* out; __device__ void operator()(int r, int c, float v) const { const size_t i = (size_t)r * D + c; out[i] = v * bf2f(gate[i]); } };
struct EpiMix { const float* t1; const bf16_t* gate; bf16_t* out; __device__ void operator()(int r, int c, float v) const { const size_t i = (size_t)r * D + c; out[i] = f2bf(t1[i] + v * bf2f(gate[i])); } };
struct EpiRes { const float* rp; const float* rs; float* out; __device__ void operator()(int r, int c, float v) const {
    const float res = r < MP ? rp[(size_t)r * D + c] : rs[(size_t)(r - MP) * D + c]; out[(size_t)r * D + c] = res + v; } };
struct EpiFinal { float* y; const float* tpe; __device__ void operator()(int r, int c, float v) const { const size_t i = (size_t)r * D + c; y[i] = y[i] + tpe[i] * sigmoidf_(v); } };

struct PostIn { const bf16_t* Z; const float *g_q, *g_k; bf16_t *QD, *KD, *VD, *QR, *KR, *VR, *GRS, *GD, *GT; float *kp, *ks, *vp, *vs; };
__global__ void __launch_bounds__(256) k_post_in(PostIn p) {
    const int m = blockIdx.x, tid = threadIdx.x; int b, t, pos; row_info(m, b, t, pos);
    const bf16_t* z = p.Z + (size_t)m * DIN;
    float* kout = m < MP ? p.kp + (size_t)m * 512 : p.ks + (size_t)(m - MP) * 512;
    float* vout = m < MP ? p.vp + (size_t)m * 512 : p.vs + (size_t)(m - MP) * 512;
    {
        const int c = tid * 2; const float q0 = bf2f(z[c]), q1 = bf2f(z[c + 1]), k0 = bf2f(z[512 + c]), k1 = bf2f(z[512 + c + 1]);
        float sq = q0 * q0 + q1 * q1, sk = k0 * k0 + k1 * k1;
#pragma unroll
        for (int o = 1; o < 32; o <<= 1) { sq += __shfl_xor(sq, o); sk += __shfl_xor(sk, o); }
        const float rq = rsqrtf(sq * (1.f / 64.f) + EPS) * 0.125f, rk = rsqrtf(sk * (1.f / 64.f) + EPS);
        const int d = c & 63;
        p.QD[(size_t)m * 512 + c] = f2bf(q0 * rq * p.g_q[d]); p.QD[(size_t)m * 512 + c + 1] = f2bf(q1 * rq * p.g_q[d + 1]);
        const float kn0 = k0 * rk * p.g_k[d], kn1 = k1 * rk * p.g_k[d + 1];
        p.KD[(size_t)m * 512 + c] = f2bf(kn0); p.KD[(size_t)m * 512 + c + 1] = f2bf(kn1); kout[c] = kn0; kout[c + 1] = kn1;
        const float v0 = bf2f(z[1024 + c]), v1 = bf2f(z[1024 + c + 1]);
        p.VD[(size_t)m * 512 + c] = z[1024 + c]; p.VD[(size_t)m * 512 + c + 1] = z[1024 + c + 1]; vout[c] = v0; vout[c + 1] = v1;
    }
    {
        const int h = tid >> 6, i = tid & 63;
        const float inv = powf(10000.f, -(float)i / 64.f); const float ang = (float)pos * inv; float sn, cs; sincosf(ang, &sn, &cs);
        const float q1 = bf2f(z[1536 + h * 128 + i]), q2 = bf2f(z[1536 + h * 128 + 64 + i]);
        p.QR[(size_t)m * 512 + h * 128 + i] = f2bf(q1 * cs - q2 * sn); p.QR[(size_t)m * 512 + h * 128 + 64 + i] = f2bf(q1 * sn + q2 * cs);
        const float k1 = bf2f(z[2048 + h * 128 + i]), k2 = bf2f(z[2048 + h * 128 + 64 + i]); const float sc = 0.08838834764831845f;
        p.KR[(size_t)m * 512 + h * 128 + i] = f2bf((k1 * cs - k2 * sn) * sc); p.KR[(size_t)m * 512 + h * 128 + 64 + i] = f2bf((k1 * sn + k2 * cs) * sc);
    }
    for (int c = tid; c < 512; c += 256) { p.VR[(size_t)m * 512 + c] = z[2560 + c]; const float g = bf2f(z[3072 + c]); p.GRS[(size_t)m * 512 + c] = f2bf(g * sigmoidf_(g)); }
    for (int c = tid; c < 1024; c += 256) { p.GD[(size_t)m * D + c] = f2bf(sigmoidf_(bf2f(z[3584 + c]))); p.GT[(size_t)m * D + c] = f2bf(sigmoidf_(bf2f(z[4608 + c]))); }
}

struct AttnP { const bf16_t *QD, *KD, *VD; const float *ck, *cv, *rel_bias, *lq1, *lk1, *lq2, *lk2, *g_da; bf16_t* OD; int bid0, pad; };
__global__ void __launch_bounds__(256) k_attn(AttnP p) {
    __shared__ __attribute__((aligned(16))) bf16_t Ks[64][136];
    __shared__ __attribute__((aligned(16))) bf16_t Vs[64][136];
    __shared__ __attribute__((aligned(16))) bf16_t Qs[32][136];
    __shared__ float As[32][65];
    __shared__ float btab[192];
    __shared__ float lam_s;
    const int tid = threadIdx.x; int bid = blockIdx.x + p.bid0;
    int sample, b, h, q0pos, qrow0, nk;
    if (bid < 16 * 4 * 64) { sample = 0; const int qb = bid & 63; h = (bid >> 6) & 3; b = bid >> 8; q0pos = qb * 32; qrow0 = b * TP + qb * 32; nk = ((qb >> 1) + 1) * 64; }
    else { bid -= 16 * 4 * 64; sample = 1; h = bid & 3; b = bid >> 2; q0pos = PAST; qrow0 = MP + b * TS; nk = PAST + TS; }
    if (tid < 192) btab[tid] = p.rel_bias[t5_bucket(tid - 127) * 4 + h];
    if (tid == 0) { float a = 0.f, c = 0.f; for (int i = 0; i < 64; ++i) { a += p.lq1[i] * p.lk1[i]; c += p.lq2[i] * p.lk2[i]; } lam_s = __expf(a) - __expf(c) + LAM_INIT; }
    for (int e = tid; e < 32 * 128; e += 256) { const int r = e >> 7, c = e & 127; Qs[r][c] = p.QD[(size_t)(qrow0 + r) * 512 + h * 128 + c]; }
    const int qi = tid >> 3, part = tid & 7; const int qpos = q0pos + qi;
    const int ntile = (nk + 63) / 64;
    float m1 = -1e30f, l1 = 0.f, m2 = -1e30f, l2 = 0.f;
    float o[16];
#pragma unroll
    for (int i = 0; i < 16; ++i) o[i] = 0.f;
    for (int sweep = 0; sweep < 2; ++sweep) {
        for (int tl = 0; tl < ntile; ++tl) {
            __syncthreads();
            for (int e = tid; e < 64 * 128; e += 256) { const int r = e >> 7, c = e & 127; const int j = tl * 64 + r; bf16_t kv = 0, vv = 0;
                if (j < nk) {
                    if (!sample) { const size_t row = (size_t)b * TP + j; kv = p.KD[row * 512 + h * 128 + c]; vv = p.VD[row * 512 + h * 128 + c]; }
                    else if (j < PAST) { const size_t o_ = (((size_t)b * PAST + j) * 4 + h) * 128 + c; kv = f2bf(p.ck[o_]); vv = f2bf(p.cv[o_]); }
                    else { const size_t row = (size_t)MP + b * TS + (j - PAST); kv = p.KD[row * 512 + h * 128 + c]; vv = p.VD[row * 512 + h * 128 + c]; }
                }
                Ks[r][c] = kv; Vs[r][c] = vv; }
            __syncthreads();
            float s1[8], s2[8];
#pragma unroll
            for (int kk = 0; kk < 8; ++kk) { const int r = part * 8 + kk; float a1 = 0.f, a2 = 0.f;
                for (int d = 0; d < 64; ++d) { a1 += bf2f(Qs[qi][d]) * bf2f(Ks[r][d]); a2 += bf2f(Qs[qi][64 + d]) * bf2f(Ks[r][64 + d]); }
                const int j = tl * 64 + r; const int rel = j - qpos; const float bias = rel < -127 ? btab[0] : btab[rel + 127];
                s1[kk] = j < nk ? a1 + bias : -1e30f; s2[kk] = j < nk ? a2 + bias : -1e30f; }
            if (sweep == 0) {
#pragma unroll
                for (int kk = 0; kk < 8; ++kk) {
                    if (s1[kk] > -1e29f) { if (s1[kk] > m1) { l1 = l1 * __expf(m1 - s1[kk]) + 1.f; m1 = s1[kk]; } else l1 += __expf(s1[kk] - m1); }
                    if (s2[kk] > -1e29f) { if (s2[kk] > m2) { l2 = l2 * __expf(m2 - s2[kk]) + 1.f; m2 = s2[kk]; } else l2 += __expf(s2[kk] - m2); } }
            } else {
                const float lam = lam_s;
#pragma unroll
                for (int kk = 0; kk < 8; ++kk) { const float a = s1[kk] > -1e29f ? __expf(s1[kk] - m1) * l1 - lam * __expf(s2[kk] - m2) * l2 : 0.f; As[qi][part * 8 + kk] = a; }
                __syncthreads();
                for (int r = 0; r < 64; ++r) { const float a = As[qi][r];
#pragma unroll
                    for (int i = 0; i < 16; ++i) o[i] += a * bf2f(Vs[r][part * 16 + i]); }
            }
        }
        if (sweep == 0) {
            float M1 = m1, M2 = m2;
#pragma unroll
            for (int of = 1; of < 8; of <<= 1) { M1 = fmaxf(M1, __shfl_xor(M1, of)); M2 = fmaxf(M2, __shfl_xor(M2, of)); }
            float L1 = l1 * __expf(m1 - M1), L2 = l2 * __expf(m2 - M2);
#pragma unroll
            for (int of = 1; of < 8; of <<= 1) { L1 += __shfl_xor(L1, of); L2 += __shfl_xor(L2, of); }
            m1 = M1; m2 = M2; l1 = 1.f / L1; l2 = 1.f / L2;
        }
    }
    float ss = 0.f;
#pragma unroll
    for (int i = 0; i < 16; ++i) ss += o[i] * o[i];
#pragma unroll
    for (int of = 1; of < 8; of <<= 1) ss += __shfl_xor(ss, of);
    const float rstd = rsqrtf(ss * (1.f / 128.f) + EPS) * (1.f - LAM_INIT);
#pragma unroll
    for (int i = 0; i < 16; ++i) p.OD[(size_t)(qrow0 + qi) * 512 + h * 128 + part * 16 + i] = f2bf(o[i] * rstd * p.g_da[part * 16 + i]);
}

struct RetP { const bf16_t *QR, *KR, *VR, *GRS; const float *s0, *g_rt; bf16_t* OR; float *rp, *rs; };
__global__ void __launch_bounds__(256) k_ret(RetP p) {
    __shared__ float qs[128], ks[128], vs[128], part[2][128], red[2];
    const int tid = threadIdx.x, e = tid & 127, dh = tid >> 7; int bid = blockIdx.x;
    int sample, b, h, row0, T;
    if (bid < 64) { sample = 0; h = bid & 3; b = bid >> 2; row0 = b * TP; T = TP; } else { bid -= 64; sample = 1; h = bid & 3; b = bid >> 2; row0 = MP + b * TS; T = TS; }
    const float gamma = 1.f - exp2f(-5.f - (float)h);
    float S[64];
#pragma unroll
    for (int i = 0; i < 64; ++i) S[i] = sample ? p.s0[(((size_t)b * 4 + h) * 128 + dh * 64 + i) * 128 + e] : 0.f;
    for (int n = 0; n < T; ++n) {
        const size_t base = (size_t)(row0 + n) * 512 + h * 128;
        __syncthreads();
        if (tid < 128) { qs[tid] = bf2f(p.QR[base + tid]); ks[tid] = bf2f(p.KR[base + tid]); } else { vs[tid - 128] = bf2f(p.VR[base + tid - 128]); }
        __syncthreads();
        const float ve = vs[e]; float po = 0.f;
#pragma unroll
        for (int i = 0; i < 64; ++i) { S[i] = gamma * S[i] + ks[dh * 64 + i] * ve; po += qs[dh * 64 + i] * S[i]; }
        part[dh][e] = po;
        __syncthreads();
        float ov = 0.f, sq = 0.f;
        if (tid < 128) { ov = part[0][e] + part[1][e]; sq = ov * ov; }
#pragma unroll
        for (int of = 1; of < 64; of <<= 1) sq += __shfl_xor(sq, of);
        if (tid < 128 && (tid & 63) == 0) red[tid >> 6] = sq;
        __syncthreads();
        if (tid < 128) { const float rstd = rsqrtf((red[0] + red[1]) * (1.f / 128.f) + EPS);
            p.OR[base + e] = f2bf(ov * rstd * p.g_rt[e] * bf2f(p.GRS[base + e])); }
    }
    float* so = sample ? p.rs : p.rp;
#pragma unroll
    for (int i = 0; i < 64; ++i) so[(((size_t)b * 4 + h) * 128 + dh * 64 + i) * 128 + e] = S[i];
}

struct ConvP { const bf16_t *G, *U; const float *sc, *cw, *cb; bf16_t* ACT; float *cp, *cs; };
__global__ void __launch_bounds__(256) k_conv(ConvP p) {
    const int m = blockIdx.x; int b, t, pos; row_info(m, b, t, pos); const bool sample = m >= MP; const int T = sample ? TS : TP;
    for (int j = threadIdx.x; j < DFF; j += 256) {
        const float g0 = bf2f(p.G[(size_t)m * DFF + j]);
        const float g1 = t >= 1 ? bf2f(p.G[(size_t)(m - 1) * DFF + j]) : (sample ? p.sc[((size_t)b * 2 + 1) * DFF + j] : 0.f);
        const float g2 = t >= 2 ? bf2f(p.G[(size_t)(m - 2) * DFF + j]) : (sample ? p.sc[((size_t)b * 2 + t) * DFF + j] : 0.f);
        const float gc = p.cb[j] + g2 * p.cw[j] + g1 * p.cw[DFF + j] + g0 * p.cw[2 * DFF + j];
        p.ACT[(size_t)m * DFF + j] = f2bf(gelu_tanh(gc) * bf2f(p.U[(size_t)m * DFF + j]));
        if (t >= T - 2) { float* co = sample ? p.cs : p.cp; co[((size_t)b * 2 + (t - (T - 2))) * DFF + j] = g0; }
    }
}

#include <cstring>
namespace pg8 {
#define PG8_LAS __attribute__((address_space(3)))
typedef unsigned short bf16_t;
typedef short bf16x8 __attribute__((ext_vector_type(8)));
typedef float f32x4 __attribute__((ext_vector_type(4)));
typedef unsigned u32x4 __attribute__((ext_vector_type(4)));
constexpr int BM = 256, BK = 64, HALF = 128, HTB = HALF * BK * 2  , STAGE_BYTES = 8 * HTB, NXCD = 8, WGM = 8;

__host__ __device__ __forceinline__ int lds_byte(int r, int c) { const int st = (r >> 4) * 2 + (c >> 5), rr = r & 15, cc = c & 31, ob = rr * 64 + cc * 2; return st * 1024 + (ob ^ (((ob >> 9) & 1) << 5)); }
__host__ __device__ __forceinline__ void stage_rc(int b, int& R, int& C) { const int st = b / 1024, sb = b % 1024, swz = sb ^ (((sb >> 9) & 1) << 5); R = (st >> 1) * 16 + swz / 64; C = (st & 1) * 32 + (swz % 64) / 2; }
__host__ __device__ __forceinline__ int perm32(int rho) { const int n = rho >> 4, i = rho & 15; return 8 * (i >> 2) + 4 * n + (i & 3); }

struct Unit { int pm, pn; };
struct Gemm { const bf16_t* A; const bf16_t* Bt; int M, N, K; };

struct StaticOrder {
    int nM, nN, nwg, G, c;
    __host__ __device__ void init(int M, int N, int G_, int c_) { nM = M / BM; nN = N / BM; nwg = nM * nN; G = G_; c = c_; }
    __host__ __device__ bool next(int i, Unit& u) const {
        const long L = (long)i * G + c; if (L >= nwg) return false;
        int wgid = (int)L; { const int q = nwg / NXCD, r = nwg % NXCD, xcd = wgid % NXCD, off = wgid / NXCD; wgid = (xcd < r ? xcd * (q + 1) : r * (q + 1) + (xcd - r) * q) + off; }
        const int nig = WGM * nN, gid = wgid / nig, fm = gid * WGM, gsz = (nM - fm) < WGM ? (nM - fm) : WGM;
        u.pm = fm + ((wgid % nig) % gsz); u.pn = (wgid % nig) / gsz; return true;
    }
    __device__ __forceinline__ void a_ready(const Unit&) const {}
    __device__ __forceinline__ void done(const Unit&) const {}
};

__device__ __forceinline__ unsigned cvt_pk_bf16(float lo, float hi) { unsigned r; asm volatile("v_cvt_pk_bf16_f32 %0, %1, %2" : "=v"(r) : "v"(lo), "v"(hi)); return r; }
typedef float f32x2 __attribute__((ext_vector_type(2)));
__device__ __forceinline__ f32x2 gelu_pk(f32x2 v) {
    const f32x2 av = __builtin_elementwise_abs(v), d = av * 0.2316418882f + 1.0f;
    f32x2 t; t.x = __builtin_amdgcn_rcpf(d.x); t.y = __builtin_amdgcn_rcpf(d.y);
    f32x2 q = t * 0.5307027145f + (-0.7265760135f); q = q * t + 0.7107068705f; q = q * t + (-0.142248368f); q = q * t + 0.127414796f; q = q * t;
    const f32x2 s = (v * v) * (-0.72134752044f);
    f32x2 e; e.x = __builtin_amdgcn_exp2f(s.x); e.y = __builtin_amdgcn_exp2f(s.y);
    const f32x2 m = v * (q * e), r = v - m;
    f32x2 o; o.x = v.x < 0.f ? m.x : r.x; o.y = v.y < 0.f ? m.y : r.y; return o;
}


typedef __bf16 bf16x2_t __attribute__((ext_vector_type(2)));
__device__ __forceinline__ unsigned cvtpk(float lo, float hi) { f32x2 v = {lo, hi}; bf16x2_t b = __builtin_convertvector(v, bf16x2_t); return __builtin_bit_cast(unsigned, b); }
__device__ __forceinline__ u32x4 pack8(f32x4 a, f32x4 b) { u32x4 w; w.x = cvtpk(a[0], a[1]); w.y = cvtpk(a[2], a[3]); w.z = cvtpk(b[0], b[1]); w.w = cvtpk(b[2], b[3]); return w; }
__device__ __forceinline__ float fsig(float x) { return __builtin_amdgcn_rcpf(1.f + __builtin_amdgcn_exp2f(-1.4426950408889634f * x)); }
__device__ __forceinline__ f32x4 fsig4(f32x4 x) { return (f32x4){fsig(x[0]), fsig(x[1]), fsig(x[2]), fsig(x[3])}; }

constexpr int E_MP = 32768;
struct EpiIn {
    static constexpr bool PERM = true, AFTER_DRAIN = false;
    bf16_t *QD, *KD, *VD, *QR, *KR, *VR, *GRS, *GD, *GT; float *kp, *ks, *vp, *vs; const float *g_q, *g_k; const float* rot;
    __device__ __forceinline__ void operator()(const f32x4 (&acc)[2][2][4][2], const Unit& u, int wr, int wc, int fr, int fq) const {
        const int pn = u.pn; const int rbase = u.pm * BM + wr * 64 + fr; const bool samp = u.pm >= E_MP / BM;
        if (pn < 4) {
            const bool isq = pn < 2; const float* gg = isq ? g_q : g_k; const float sc = isq ? 0.125f : 1.f;
            f32x4 gv[2][2];
#pragma unroll
            for (int bj = 0; bj < 2; ++bj)
#pragma unroll
                for (int n = 0; n < 2; ++n) gv[bj][n] = *(const f32x4*)(gg + 32 * bj + 8 * fq + 4 * n);
            const int col = (pn & 1) * 256 + 64 * wc + 8 * fq;
            bf16_t* dst = isq ? QD : KD; float* ko = samp ? ks - (size_t)E_MP * 512 : kp;
#pragma unroll
            for (int ai = 0; ai < 2; ++ai)
#pragma unroll
                for (int m = 0; m < 4; ++m) { const size_t row = (size_t)(rbase + ai * HALF + m * 16);
                    float ss = 0.f;
#pragma unroll
                    for (int bj = 0; bj < 2; ++bj)
#pragma unroll
                        for (int n = 0; n < 2; ++n) { const f32x4 x = acc[ai][bj][m][n]; ss += (x[0] * x[0] + x[1] * x[1]) + (x[2] * x[2] + x[3] * x[3]); }
                    ss += __shfl_xor(ss, 16); ss += __shfl_xor(ss, 32);
                    const float rs = __builtin_amdgcn_rsqf(ss * (1.f / 64.f) + 1e-6f) * sc;
#pragma unroll
                    for (int bj = 0; bj < 2; ++bj) { const f32x4 v0 = acc[ai][bj][m][0] * rs * gv[bj][0], v1 = acc[ai][bj][m][1] * rs * gv[bj][1];
                        *(u32x4*)(dst + row * 512 + col + 32 * bj) = pack8(v0, v1);
                        if (!isq) { float* kr_ = ko + row * 512 + col + 32 * bj; *(f32x4*)kr_ = v0; *(f32x4*)(kr_ + 4) = v1; } } }
        } else if (pn < 6) {
            const int col = (pn - 4) * 256 + 32 * wc + 8 * fq; float* vo = samp ? vs - (size_t)E_MP * 512 : vp;
#pragma unroll
            for (int ai = 0; ai < 2; ++ai)
#pragma unroll
                for (int m = 0; m < 4; ++m) { const size_t row = (size_t)(rbase + ai * HALF + m * 16);
#pragma unroll
                    for (int bj = 0; bj < 2; ++bj) { const f32x4 v0 = acc[ai][bj][m][0], v1 = acc[ai][bj][m][1];
                        *(u32x4*)(VD + row * 512 + col + 128 * bj) = pack8(v0, v1);
                        float* vr_ = vo + row * 512 + col + 128 * bj; *(f32x4*)vr_ = v0; *(f32x4*)(vr_ + 4) = v1; } }
        } else if (pn < 10) {
            const bool isq = pn < 8; const int head = (pn & 1) * 2 + (wc >> 1); const int i0 = 32 * (wc & 1) + 8 * fq; const float sc = isq ? 1.f : 0.08838834764831845f;
            bf16_t* dst = isq ? QR : KR;
#pragma unroll
            for (int ai = 0; ai < 2; ++ai)
#pragma unroll
                for (int m = 0; m < 4; ++m) { const int rowi = rbase + ai * HALF + m * 16; const size_t row = (size_t)rowi;
                    const int pidx = samp ? 2048 + ((rowi - E_MP) & 31) : (rowi & 2047);
                    const f32x4* rt = (const f32x4*)(rot + ((size_t)pidx * 64 + i0) * 2);
                    f32x4 o1[2], o2[2];
#pragma unroll
                    for (int n = 0; n < 2; ++n) { const f32x4 ra = rt[2 * n], rb = rt[2 * n + 1]; const f32x4 x1 = acc[ai][0][m][n], x2 = acc[ai][1][m][n];
                        const f32x4 cs = (f32x4){ra[0], ra[2], rb[0], rb[2]}, sn = (f32x4){ra[1], ra[3], rb[1], rb[3]};
                        o1[n] = (x1 * cs - x2 * sn) * sc; o2[n] = (x1 * sn + x2 * cs) * sc; }
                    *(u32x4*)(dst + row * 512 + head * 128 + i0) = pack8(o1[0], o1[1]);
                    *(u32x4*)(dst + row * 512 + head * 128 + 64 + i0) = pack8(o2[0], o2[1]); }
        } else if (pn < 14) {
            const bool isv = pn < 12; const int col = (pn & 1) * 256 + 32 * wc + 8 * fq; bf16_t* dst = isv ? VR : GRS;
#pragma unroll
            for (int ai = 0; ai < 2; ++ai)
#pragma unroll
                for (int m = 0; m < 4; ++m) { const size_t row = (size_t)(rbase + ai * HALF + m * 16);
#pragma unroll
                    for (int bj = 0; bj < 2; ++bj) { f32x4 v0 = acc[ai][bj][m][0], v1 = acc[ai][bj][m][1];
                        if (!isv) { v0 = v0 * fsig4(v0); v1 = v1 * fsig4(v1); }
                        *(u32x4*)(dst + row * 512 + col + 128 * bj) = pack8(v0, v1); } }
        } else {
            const bool isd = pn < 18; const int col = ((pn - 14) & 3) * 256 + 32 * wc + 8 * fq; bf16_t* dst = isd ? GD : GT;
#pragma unroll
            for (int ai = 0; ai < 2; ++ai)
#pragma unroll
                for (int m = 0; m < 4; ++m) { const size_t row = (size_t)(rbase + ai * HALF + m * 16);
#pragma unroll
                    for (int bj = 0; bj < 2; ++bj) { const f32x4 v0 = fsig4(acc[ai][bj][m][0]), v1 = fsig4(acc[ai][bj][m][1]);
                        *(u32x4*)(dst + row * 1024 + col + 128 * bj) = pack8(v0, v1); } }
        }
    }
};
struct EpiResid {
    static constexpr bool PERM = true, AFTER_DRAIN = false;
    const float* rp; const float* rs; float* out;
    __device__ __forceinline__ void operator()(const f32x4 (&acc)[2][2][4][2], const Unit& u, int wr, int wc, int fr, int fq) const {
        const int rbase = u.pm * BM + wr * 64 + fr; const bool samp = u.pm >= E_MP / BM; const int col = u.pn * 256 + 32 * wc + 8 * fq;
        const float* res = samp ? rs - (size_t)E_MP * 1024 : rp;
#pragma unroll
        for (int ai = 0; ai < 2; ++ai)
#pragma unroll
            for (int m = 0; m < 4; ++m) { const size_t row = (size_t)(rbase + ai * HALF + m * 16);
#pragma unroll
                for (int bj = 0; bj < 2; ++bj) { const size_t o = row * 1024 + col + 128 * bj;
                    const f32x4 r0 = *(const f32x4*)(res + o), r1 = *(const f32x4*)(res + o + 4);
                    *(f32x4*)(out + o) = r0 + acc[ai][bj][m][0]; *(f32x4*)(out + o + 4) = r1 + acc[ai][bj][m][1]; } }
    }
};

__device__ __forceinline__ void unpack8(u32x4 w, f32x4& a, f32x4& b) {
    a = (f32x4){__uint_as_float(w.x << 16), __uint_as_float(w.x & 0xffff0000u), __uint_as_float(w.y << 16), __uint_as_float(w.y & 0xffff0000u)};
    b = (f32x4){__uint_as_float(w.z << 16), __uint_as_float(w.z & 0xffff0000u), __uint_as_float(w.w << 16), __uint_as_float(w.w & 0xffff0000u)};
}
struct EpiGateT1 {
    static constexpr bool PERM = true, AFTER_DRAIN = false;
    const bf16_t* gate; float* t1;
    __device__ __forceinline__ void operator()(const f32x4 (&acc)[2][2][4][2], const Unit& u, int wr, int wc, int fr, int fq) const {
        const int rbase = u.pm * BM + wr * 64 + fr; const int col = u.pn * 256 + 32 * wc + 8 * fq;
#pragma unroll
        for (int ai = 0; ai < 2; ++ai)
#pragma unroll
            for (int m = 0; m < 4; ++m) { const size_t row = (size_t)(rbase + ai * HALF + m * 16);
#pragma unroll
                for (int bj = 0; bj < 2; ++bj) { const size_t o = row * 1024 + col + 128 * bj; f32x4 g0, g1; unpack8(*(const u32x4*)(gate + o), g0, g1);
                    *(f32x4*)(t1 + o) = acc[ai][bj][m][0] * g0; *(f32x4*)(t1 + o + 4) = acc[ai][bj][m][1] * g1; } }
    }
};
struct EpiMixOut {
    static constexpr bool PERM = true, AFTER_DRAIN = false;
    const bf16_t* gate; const float* t1; bf16_t* mix;
    __device__ __forceinline__ void operator()(const f32x4 (&acc)[2][2][4][2], const Unit& u, int wr, int wc, int fr, int fq) const {
        const int rbase = u.pm * BM + wr * 64 + fr; const int col = u.pn * 256 + 32 * wc + 8 * fq;
#pragma unroll
        for (int ai = 0; ai < 2; ++ai)
#pragma unroll
            for (int m = 0; m < 4; ++m) { const size_t row = (size_t)(rbase + ai * HALF + m * 16);
#pragma unroll
                for (int bj = 0; bj < 2; ++bj) { const size_t o = row * 1024 + col + 128 * bj; f32x4 g0, g1; unpack8(*(const u32x4*)(gate + o), g0, g1);
                    const f32x4 a0 = *(const f32x4*)(t1 + o) + acc[ai][bj][m][0] * g0, a1 = *(const f32x4*)(t1 + o + 4) + acc[ai][bj][m][1] * g1;
                    *(u32x4*)(mix + o) = pack8(a0, a1); } }
    }
};
struct EpiResNorm {
    static constexpr bool PERM = true, AFTER_DRAIN = false;
    const float* rp; const float* rs; float* hout; bf16_t* hb; float* ss;
    __device__ __forceinline__ void operator()(const f32x4 (&acc)[2][2][4][2], const Unit& u, int wr, int wc, int fr, int fq) const {
        const int rbase = u.pm * BM + wr * 64 + fr; const bool samp = u.pm >= E_MP / BM; const int col = u.pn * 256 + 32 * wc + 8 * fq;
        const float* res = samp ? rs - (size_t)E_MP * 1024 : rp;
#pragma unroll
        for (int ai = 0; ai < 2; ++ai)
#pragma unroll
            for (int m = 0; m < 4; ++m) { const size_t row = (size_t)(rbase + ai * HALF + m * 16); float sq = 0.f;
#pragma unroll
                for (int bj = 0; bj < 2; ++bj) { const size_t o = row * 1024 + col + 128 * bj;
                    const f32x4 h0 = *(const f32x4*)(res + o) + acc[ai][bj][m][0], h1 = *(const f32x4*)(res + o + 4) + acc[ai][bj][m][1];
                    *(f32x4*)(hout + o) = h0; *(f32x4*)(hout + o + 4) = h1; *(u32x4*)(hb + o) = pack8(h0, h1);
                    sq += (h0[0] * h0[0] + h0[1] * h0[1]) + (h0[2] * h0[2] + h0[3] * h0[3]) + (h1[0] * h1[0] + h1[1] * h1[1]) + (h1[2] * h1[2] + h1[3] * h1[3]); }
                sq += __shfl_xor(sq, 16); sq += __shfl_xor(sq, 32);
                if (fq == 0) ss[row * 16 + u.pn * 4 + wc] = sq;
                asm volatile("" ::: "memory"); }
    }
};
__device__ __forceinline__ void rstd_table(PG8_LAS float* tab, const float* ss, int pm) {
    const int tid = threadIdx.x;
    if (tid < 256) { const f32x4* p = (const f32x4*)(ss + (size_t)(pm * BM + tid) * 16); const f32x4 a = p[0], b = p[1], c = p[2], d = p[3];
        const float s = ((a[0] + a[1]) + (a[2] + a[3])) + ((b[0] + b[1]) + (b[2] + b[3])) + ((c[0] + c[1]) + (c[2] + c[3])) + ((d[0] + d[1]) + (d[2] + d[3]));
        tab[tid] = __builtin_amdgcn_rsqf(s * (1.f / 1024.f) + 1e-6f); }
    asm volatile("s_waitcnt lgkmcnt(0)" ::: "memory"); __builtin_amdgcn_s_barrier(); asm volatile("" ::: "memory");
}
__device__ __forceinline__ float gelu_t(float x) {
    const float w = x * (-2.3022082f - 0.10294324f * (x * x)); return x * __builtin_amdgcn_rcpf(1.f + __builtin_amdgcn_exp2f(w));
}
constexpr int E_DFF = 2816;
struct EpiGU {
    static constexpr bool PERM = true, AFTER_DRAIN = false;
    const float* ss; const float* sc; const float* cw; const float* cb; bf16_t* act; float* headp; float* headu; float* tail; float* cp; float* cs; PG8_LAS float* tab;
    __device__ __forceinline__ void operator()(const f32x4 (&acc)[2][2][4][2], const Unit& u, int wr, int wc, int fr, int fq) const {
        rstd_table(tab, ss, u.pm);
        const int lane = threadIdx.x & 63; const bool samp = u.pm >= E_MP / BM;
        const int src1 = (lane & 48) | ((fr + 15) & 15), src2 = (lane & 48) | ((fr + 14) & 15);
#pragma unroll
        for (int n = 0; n < 2; ++n) {
            const int j0 = u.pn * 128 + 32 * wc + 8 * fq + 4 * n;
            const f32x4 w0 = *(const f32x4*)(cw + j0), w1 = *(const f32x4*)(cw + E_DFF + j0), w2 = *(const f32x4*)(cw + 2 * E_DFF + j0), bb = *(const f32x4*)(cb + j0);
#pragma unroll
            for (int ai = 0; ai < 2; ++ai) {
                const int r0t = ai * HALF + wr * 64;
                const int grow0 = u.pm * BM + r0t;
                f32x4 xm1 = (f32x4){0.f, 0.f, 0.f, 0.f};
#pragma unroll
                for (int m = 0; m < 4; ++m) {
                    const int rowi = grow0 + m * 16 + fr; const float rs = tab[r0t + m * 16 + fr];
                    const f32x4 g = acc[ai][0][m][n] * rs, uu = acc[ai][1][m][n] * rs;
                    if (samp && (m & 1) == 0) { const int b = (rowi - fr - E_MP) >> 5; const int sr = fr >= 14 ? fr - 14 : 0; xm1 = *(const f32x4*)(sc + ((size_t)b * 2 + sr) * E_DFF + j0); }
                    f32x4 gc;
#pragma unroll
                    for (int i = 0; i < 4; ++i) { const float y1 = fr == 15 ? xm1[i] : g[i], y2 = fr >= 14 ? xm1[i] : g[i];
                        const float p1 = __shfl(y1, src1), p2 = __shfl(y2, src2);
                        gc[i] = bb[i] + w0[i] * p2 + w1[i] * p1 + w2[i] * g[i]; }
                    const bool head = !samp && m == 0 && fr < 2;
                    if (head) { const size_t o = ((size_t)(grow0 >> 6) * 2 + fr) * E_DFF + j0; *(f32x4*)(headp + o) = gc; *(f32x4*)(headu + o) = uu; }
                    else { uint2 w; w.x = cvtpk(gelu_t(gc[0]) * uu[0], gelu_t(gc[1]) * uu[1]); w.y = cvtpk(gelu_t(gc[2]) * uu[2], gelu_t(gc[3]) * uu[3]);
                        *(uint2*)(act + (size_t)rowi * E_DFF + j0) = w; }
                    if (fr >= 14) {
                        if (samp) { if (m & 1) { const int b = (rowi - E_MP) >> 5; *(f32x4*)(cs + ((size_t)b * 2 + (fr - 14)) * E_DFF + j0) = g; } }
                        else if (m == 3) { *(f32x4*)(tail + ((size_t)(grow0 >> 6) * 2 + (fr - 14)) * E_DFF + j0) = g;
                            if (((grow0 + 64) & 2047) == 0) *(f32x4*)(cp + ((size_t)(grow0 >> 11) * 2 + (fr - 14)) * E_DFF + j0) = g; } }
                    xm1 = g;
                }
            }
        }
    }
};
struct EpiStoreF32 {
    static constexpr bool PERM = true, AFTER_DRAIN = false;
    float* out;
    __device__ __forceinline__ void operator()(const f32x4 (&acc)[2][2][4][2], const Unit& u, int wr, int wc, int fr, int fq) const {
        const int rbase = u.pm * BM + wr * 64 + fr; const int col = u.pn * 256 + 32 * wc + 8 * fq;
#pragma unroll
        for (int ai = 0; ai < 2; ++ai)
#pragma unroll
            for (int m = 0; m < 4; ++m) { const size_t row = (size_t)(rbase + ai * HALF + m * 16);
#pragma unroll
                for (int bj = 0; bj < 2; ++bj) { const size_t o = row * 1024 + col + 128 * bj; *(f32x4*)(out + o) = acc[ai][bj][m][0]; *(f32x4*)(out + o + 4) = acc[ai][bj][m][1]; } }
    }
};
struct EpiFinalY {
    static constexpr bool PERM = true, AFTER_DRAIN = false;
    const float* ss; const float* tpe; float* y; PG8_LAS float* tab;
    __device__ __forceinline__ void operator()(const f32x4 (&acc)[2][2][4][2], const Unit& u, int wr, int wc, int fr, int fq) const {
        rstd_table(tab, ss, u.pm);
        const int rbase = u.pm * BM + wr * 64 + fr; const int col = u.pn * 256 + 32 * wc + 8 * fq;
#pragma unroll
        for (int ai = 0; ai < 2; ++ai)
#pragma unroll
            for (int m = 0; m < 4; ++m) { const size_t row = (size_t)(rbase + ai * HALF + m * 16); const float rs = tab[ai * HALF + wr * 64 + m * 16 + fr];
#pragma unroll
                for (int bj = 0; bj < 2; ++bj) { const size_t o = row * 1024 + col + 128 * bj;
                    const f32x4 s0 = fsig4(acc[ai][bj][m][0] * rs), s1 = fsig4(acc[ai][bj][m][1] * rs);
                    *(f32x4*)(y + o) = *(const f32x4*)(y + o) + *(const f32x4*)(tpe + o) * s0; *(f32x4*)(y + o + 4) = *(const f32x4*)(y + o + 4) + *(const f32x4*)(tpe + o + 4) * s1; }
                asm volatile("" ::: "memory"); }
    }
};
template <class Epi, class Sched, bool ALIGN_EPI = false, bool SP2 = false>
__device__ __forceinline__ void gemm_phase(PG8_LAS unsigned char* lds, const Gemm g, const Sched& S, const Epi& E) {
    const int tid = threadIdx.x, wid = __builtin_amdgcn_readfirstlane(tid >> 6), lane = tid & 63, wr = wid >> 2, wc = wid & 3, fr = lane & 15, fq = lane >> 4;
    const int K = g.K, nt = K / BK;
    unsigned voffA[2], voffB[2];
#pragma unroll
    for (int i = 0; i < 2; ++i) { int R, C; stage_rc(tid * 16 + i * 8192, R, C); const int Rb = Epi::PERM ? ((R & ~31) + perm32(R & 31)) : R;
        voffA[i] = (unsigned)(R * K + C) * 2u; voffB[i] = (unsigned)(Rb * K + C) * 2u; }
    const size_t kstep = (size_t)(BK * 2);
    const size_t hstep = (size_t)HALF * K * 2;
    const size_t tstep = 2 * hstep;
    const unsigned ldsw = (unsigned)wid * 1024u;
    const int aoff = lds_byte(wr * 64 + fr, fq * 8), boff = lds_byte(wc * 32 + fr, fq * 8);
#define PG8_SA(b, h) (((b) * 2 + (h)) * HTB)
#define PG8_SB(b, h) ((4 + (b) * 2 + (h)) * HTB)
#define PG8_STAGE(bufoff, gbase, voff) do { _Pragma("unroll") for (int _i = 0; _i < 2; ++_i) \
        __builtin_amdgcn_global_load_lds((const unsigned*)((const char*)(gbase) + (voff)[_i]), (PG8_LAS unsigned*)(lds + (bufoff) + ldsw + _i * 8192), 16, 0, 0); } while (0)
#define PG8_LDA(dst, b, h) do { _Pragma("unroll") for (int m = 0; m < 4; ++m) _Pragma("unroll") for (int k = 0; k < 2; ++k) dst[m][k] = *(const PG8_LAS bf16x8*)(lds + PG8_SA(b, h) + aoff + m * 2048 + k * 1024); } while (0)
#define PG8_LDB(dst, b, h) do { _Pragma("unroll") for (int n = 0; n < 2; ++n) _Pragma("unroll") for (int k = 0; k < 2; ++k) dst[n][k] = *(const PG8_LAS bf16x8*)(lds + PG8_SB(b, h) + boff + n * 2048 + k * 1024); } while (0)
#define PG8_MMA(ai, bj, At, Bt) do { __builtin_amdgcn_s_setprio(1); _Pragma("unroll") for (int m = 0; m < 4; ++m) _Pragma("unroll") for (int n = 0; n < 2; ++n) _Pragma("unroll") for (int k = 0; k < 2; ++k) \
        acc[ai][bj][m][n] = __builtin_amdgcn_mfma_f32_16x16x32_bf16(Bt[n][k], At[m][k], acc[ai][bj][m][n], 0, 0, 0); __builtin_amdgcn_s_setprio(0); } while (0)
#define PG8_WAIT_V(n) asm volatile("s_waitcnt vmcnt(" #n ")" ::: "memory")
#define PG8_WAIT_L(n) asm volatile("s_waitcnt lgkmcnt(" #n ")" ::: "memory")
#define PG8_BAR __builtin_amdgcn_s_barrier()
#define PG8_SCHED __builtin_amdgcn_sched_barrier(0)
    Unit cur, nxt; int ui = 0;
    if (!S.next(0, cur)) return;
    f32x4 acc[2][2][4][2];
#pragma unroll
    for (int a = 0; a < 2; ++a)
#pragma unroll
        for (int b = 0; b < 2; ++b)
#pragma unroll
            for (int m = 0; m < 4; ++m)
#pragma unroll
                for (int n = 0; n < 2; ++n) acc[a][b][m][n] = (f32x4){0.f, 0.f, 0.f, 0.f};
    bf16x8 At[4][2], B0[2][2], B1[2][2];
    const char* cA = (const char*)g.A + (size_t)cur.pm * tstep; const char* cB = (const char*)g.Bt + (size_t)cur.pn * tstep;
    S.a_ready(cur);
    if constexpr (SP2) {
        PG8_STAGE(PG8_SB(0, 0), cB, voffB); PG8_STAGE(PG8_SB(0, 1), cB + hstep, voffB); PG8_STAGE(PG8_SA(0, 0), cA, voffA); PG8_STAGE(PG8_SA(0, 1), cA + hstep, voffA);
        if (wr == 1) PG8_BAR;
        PG8_WAIT_V(2); PG8_BAR;
        PG8_STAGE(PG8_SB(1, 0), cB + kstep, voffB); PG8_STAGE(PG8_SA(1, 0), cA + kstep, voffA); PG8_STAGE(PG8_SB(1, 1), cB + hstep + kstep, voffB);
        PG8_WAIT_V(6); PG8_BAR;
    } else {
        PG8_STAGE(PG8_SB(0, 0), cB, voffB); PG8_STAGE(PG8_SA(0, 0), cA, voffA); PG8_STAGE(PG8_SB(0, 1), cB + hstep, voffB); PG8_STAGE(PG8_SA(0, 1), cA + hstep, voffA);
        if (wr == 1) PG8_BAR;
        PG8_WAIT_V(4); PG8_BAR;
        PG8_STAGE(PG8_SB(1, 0), cB + kstep, voffB); PG8_STAGE(PG8_SA(1, 0), cA + kstep, voffA); PG8_STAGE(PG8_SB(1, 1), cB + hstep + kstep, voffB);
        PG8_WAIT_V(6); PG8_BAR;
    }
    for (;;) {
        const bool has_next = S.next(ui + 1, nxt);
        const char* nA = has_next ? (const char*)g.A + (size_t)nxt.pm * tstep : cA; const char* nB = has_next ? (const char*)g.Bt + (size_t)nxt.pn * tstep : cB;
        for (int t = 0; t < nt; t += 2) {
            const bool last = (t == nt - 2);
            const char* a1 = cA + (size_t)(t + 1) * kstep;
            const char* a2 = last ? nA : cA + (size_t)(t + 2) * kstep; const char* b2 = last ? nB : cB + (size_t)(t + 2) * kstep;
            const char* a3 = a2 + kstep; const char* b3 = b2 + kstep;
            if (last && has_next) S.a_ready(nxt);
            if constexpr (SP2) {
            PG8_LDB(B0, 0, 0); PG8_LDB(B1, 0, 1); PG8_SCHED; PG8_LDA(At, 0, 0); PG8_STAGE(PG8_SA(1, 1), a1 + hstep, voffA);
            PG8_WAIT_V(8); PG8_WAIT_L(0); PG8_BAR; PG8_MMA(0, 0, At, B0); PG8_MMA(0, 1, At, B1); PG8_BAR; PG8_SCHED;
            PG8_LDA(At, 0, 1); PG8_STAGE(PG8_SB(0, 0), b2, voffB); PG8_STAGE(PG8_SB(0, 1), b2 + hstep, voffB); PG8_STAGE(PG8_SA(0, 0), a2, voffA);
            PG8_WAIT_V(8); PG8_WAIT_L(0); PG8_BAR; PG8_MMA(1, 0, At, B0); PG8_MMA(1, 1, At, B1); PG8_BAR; PG8_SCHED;
            PG8_LDB(B0, 1, 0); PG8_LDB(B1, 1, 1); PG8_SCHED; PG8_LDA(At, 1, 0); PG8_STAGE(PG8_SA(0, 1), a2 + hstep, voffA);
            PG8_WAIT_V(8); PG8_WAIT_L(0); PG8_BAR; PG8_MMA(0, 0, At, B0); PG8_MMA(0, 1, At, B1); PG8_BAR; PG8_SCHED;
            PG8_LDA(At, 1, 1); PG8_STAGE(PG8_SB(1, 0), b3, voffB); PG8_STAGE(PG8_SB(1, 1), b3 + hstep, voffB); PG8_STAGE(PG8_SA(1, 0), a3, voffA);
            PG8_WAIT_V(8); PG8_WAIT_L(0); PG8_BAR; PG8_MMA(1, 0, At, B0); PG8_MMA(1, 1, At, B1); PG8_BAR; PG8_SCHED;
            } else {
            PG8_LDB(B0, 0, 0); PG8_SCHED; PG8_LDA(At, 0, 0); PG8_STAGE(PG8_SA(1, 1), a1 + hstep, voffA);
            PG8_WAIT_L(8); PG8_BAR; PG8_WAIT_L(0); PG8_MMA(0, 0, At, B0); PG8_BAR; PG8_SCHED;
            PG8_LDB(B1, 0, 1); PG8_STAGE(PG8_SB(0, 0), b2, voffB);
            PG8_BAR; PG8_WAIT_L(0); PG8_MMA(0, 1, At, B1); PG8_BAR;
            PG8_LDA(At, 0, 1); PG8_STAGE(PG8_SA(0, 0), a2, voffA);
            PG8_BAR; PG8_WAIT_L(0); PG8_MMA(1, 0, At, B0); PG8_BAR; PG8_SCHED;
            PG8_STAGE(PG8_SB(0, 1), b2 + hstep, voffB);
            PG8_WAIT_V(6); PG8_BAR; PG8_MMA(1, 1, At, B1); PG8_BAR;
            PG8_LDB(B0, 1, 0); PG8_SCHED; PG8_LDA(At, 1, 0); PG8_STAGE(PG8_SA(0, 1), a2 + hstep, voffA);
            PG8_WAIT_L(8); PG8_BAR; PG8_WAIT_L(0); PG8_MMA(0, 0, At, B0); PG8_BAR; PG8_SCHED;
            PG8_LDB(B1, 1, 1); PG8_STAGE(PG8_SB(1, 0), b3, voffB);
            PG8_BAR; PG8_WAIT_L(0); PG8_MMA(0, 1, At, B1); PG8_BAR;
            PG8_LDA(At, 1, 1); PG8_STAGE(PG8_SA(1, 0), a3, voffA);
            PG8_BAR; PG8_WAIT_L(0); PG8_MMA(1, 0, At, B0); PG8_BAR; PG8_SCHED;
            PG8_STAGE(PG8_SB(1, 1), b3 + hstep, voffB);
            PG8_WAIT_V(6); PG8_BAR; PG8_MMA(1, 1, At, B1); PG8_BAR;
            }
        }
        if constexpr (ALIGN_EPI) { if (wr == 0) PG8_BAR; }
        if constexpr (!Epi::AFTER_DRAIN) { E(acc, cur, wr, wc, fr, fq); S.done(cur); }
        if (!has_next) break;
#pragma unroll
        for (int a = 0; a < 2; ++a)
#pragma unroll
            for (int b = 0; b < 2; ++b)
#pragma unroll
                for (int m = 0; m < 4; ++m)
#pragma unroll
                    for (int n = 0; n < 2; ++n) acc[a][b][m][n] = (f32x4){0.f, 0.f, 0.f, 0.f};
        cur = nxt; cA = nA; cB = nB; ++ui;
        if constexpr (ALIGN_EPI) { if (wr == 1) PG8_BAR; }
    }
    PG8_WAIT_V(0);
    if constexpr (!ALIGN_EPI) { if (wr == 0) PG8_BAR; }
    PG8_BAR;
    if constexpr (Epi::AFTER_DRAIN) { E.fused(acc, cur, wr, wc, fr, fq, lds, wid, lane); S.done(cur); }
#undef PG8_SA
#undef PG8_SB
#undef PG8_STAGE
#undef PG8_LDA
#undef PG8_LDB
#undef PG8_MMA
#undef PG8_WAIT_V
#undef PG8_WAIT_L
#undef PG8_BAR
#undef PG8_SCHED
}
}

namespace att {
typedef short bf16x8 __attribute__((ext_vector_type(8)));
typedef short s16x4 __attribute__((ext_vector_type(4)));
typedef float f32x16 __attribute__((ext_vector_type(16)));
typedef float f32x4 __attribute__((ext_vector_type(4)));
typedef float f32x2 __attribute__((ext_vector_type(2)));
typedef __bf16 bf16x2_t __attribute__((ext_vector_type(2)));
typedef __attribute__((address_space(3))) unsigned char* lptr;
typedef unsigned u32x4 __attribute__((ext_vector_type(4)));
constexpr int LK = 0, LV = 32768, LQ = 65536;
constexpr float LOG2E = 1.4426950408889634f, THR = 20.f;
constexpr int E_MP = 32768;
__device__ __forceinline__ int crow(int r, int hi) { return (r & 3) + 8 * (r >> 2) + 4 * hi; }
__device__ __forceinline__ unsigned cvtpk(float lo, float hi) { f32x2 v = {lo, hi}; bf16x2_t b = __builtin_convertvector(v, bf16x2_t); return __builtin_bit_cast(unsigned, b); }
__device__ __forceinline__ s16x4 vtr(lptr p) { typedef short v4i16_t __attribute__((ext_vector_type(4))); return __builtin_bit_cast(s16x4, __builtin_amdgcn_ds_read_tr16_b64_v4i16((__attribute__((address_space(3))) v4i16_t*)p)); }
__device__ __forceinline__ float xmax32(float v) { return fmaxf(v, __shfl_xor(v, 32)); }

__device__ __forceinline__ void tile_map(f32x16 (&O)[4], float& m, float& l, lptr kb, lptr qb, lptr vb, int rel0, int nvalid,
                                         const __attribute__((address_space(3))) float* btab, __attribute__((address_space(3))) float* wsf, int r32, int hi, int dsel  ) {
    f32x16 p0 = {}, p1 = {};
    const lptr kl = kb + hi * 1024 + r32 * 16, ql = qb + hi * 512 + r32 * 16;
#pragma unroll
    for (int s = 0; s < 4; ++s) {
        const bf16x8 kf0 = *(const __attribute__((address_space(3))) bf16x8*)(kl + (2 * s) * 1024);
        const bf16x8 kf1 = *(const __attribute__((address_space(3))) bf16x8*)(kl + (2 * s) * 1024 + 512);
        const bf16x8 qf = *(const __attribute__((address_space(3))) bf16x8*)(ql + (2 * s) * 512);
        p0 = __builtin_amdgcn_mfma_f32_32x32x16_bf16(kf0, qf, p0, 0, 0, 0);
        p1 = __builtin_amdgcn_mfma_f32_32x32x16_bf16(kf1, qf, p1, 0, 0, 0);
    }
    __builtin_amdgcn_sched_barrier(0);
    if (rel0 + 63 < -127) { const float c = btab[0];
#pragma unroll
        for (int r = 0; r < 16; ++r) { p0[r] += c; p1[r] += c; } }
    else { const __attribute__((address_space(3))) float* bp = btab + (rel0 + 4 * hi - r32 + 223);
#pragma unroll
        for (int r = 0; r < 16; ++r) { p0[r] += bp[(r & 3) + 8 * (r >> 2)]; p1[r] += bp[(r & 3) + 8 * (r >> 2) + 32]; } }
    if (nvalid < 64) {
#pragma unroll
        for (int r = 0; r < 16; ++r) p1[r] = -INFINITY; }
    float mx = fmaxf(p0[0], p1[0]);
#pragma unroll
    for (int r = 1; r < 16; ++r) mx = fmaxf(mx, fmaxf(p0[r], p1[r]));
    mx = xmax32(mx);
    if (__any(mx > m + THR)) {
        const float mn = fmaxf(m, mx); const float al = __builtin_amdgcn_exp2f((m - mn) * LOG2E); m = mn; l *= al;
        if (hi == 0) wsf[r32] = al;
        asm volatile("s_waitcnt lgkmcnt(0)" ::: "memory");
#pragma unroll
        for (int r = 0; r < 16; ++r) { const float a = wsf[crow(r, hi)];
#pragma unroll
            for (int d = 0; d < 4; ++d) O[d][r] *= a; }
        asm volatile("s_waitcnt lgkmcnt(0)" ::: "memory");
    }
    __builtin_amdgcn_sched_barrier(0);
    const float nm = -m * LOG2E; float sum = 0.f;
#pragma unroll
    for (int r = 0; r < 16; ++r) { p0[r] = __builtin_amdgcn_exp2f(__builtin_fmaf(p0[r], LOG2E, nm)); p1[r] = __builtin_amdgcn_exp2f(__builtin_fmaf(p1[r], LOG2E, nm)); sum += p0[r] + p1[r]; }
    l += sum;
    bf16x8 pa[4];
    { const u32x4 w0 = {cvtpk(p0[0], p0[1]), cvtpk(p0[2], p0[3]), cvtpk(p0[4], p0[5]), cvtpk(p0[6], p0[7])}, w1 = {cvtpk(p0[8], p0[9]), cvtpk(p0[10], p0[11]), cvtpk(p0[12], p0[13]), cvtpk(p0[14], p0[15])};
      const u32x4 w2 = {cvtpk(p1[0], p1[1]), cvtpk(p1[2], p1[3]), cvtpk(p1[4], p1[5]), cvtpk(p1[6], p1[7])}, w3 = {cvtpk(p1[8], p1[9]), cvtpk(p1[10], p1[11]), cvtpk(p1[12], p1[13]), cvtpk(p1[14], p1[15])};
      pa[0] = __builtin_bit_cast(bf16x8, w0); pa[1] = __builtin_bit_cast(bf16x8, w1); pa[2] = __builtin_bit_cast(bf16x8, w2); pa[3] = __builtin_bit_cast(bf16x8, w3); }
    __builtin_amdgcn_sched_barrier(0);
    const int lane = r32 + 32 * hi;
    const lptr vp = vb + ((lane >> 4) & 1) * 32 + (lane & 3) * 8 + (4 * hi + ((lane & 15) >> 2)) * 64;
#pragma unroll
    for (int d = 0; d < 4; ++d) {
        if (dsel >= 0 && d != 0) break;
        const int db = dsel >= 0 ? dsel : d;
#pragma unroll
        for (int ks = 0; ks < 4; ++ks) { const s16x4 lo = vtr(vp + db * 4096 + ks * 1024), hh = vtr(vp + db * 4096 + ks * 1024 + 512);
            const bf16x8 vf = {lo[0], lo[1], lo[2], lo[3], hh[0], hh[1], hh[2], hh[3]};
            O[d] = __builtin_amdgcn_mfma_f32_32x32x16_bf16(pa[ks], vf, O[d], 0, 0, 0); }
        __builtin_amdgcn_sched_barrier(0);
    }
}

__device__ __forceinline__ void attn_prompt_unit(lptr L, int b, int h, int qb, const bf16_t* __restrict__ QD, const bf16_t* __restrict__ KD, const bf16_t* __restrict__ VD, bf16_t* __restrict__ OD,
                                                 const float* __restrict__ g_da, float lam, const __attribute__((address_space(3))) float* btab, __attribute__((address_space(3))) float* wsf_all) {
    const int tid = threadIdx.x, lane = tid & 63, r32 = lane & 31, hi = lane >> 5; const int wave = __builtin_amdgcn_readfirstlane(tid >> 6);
    const int map = wave >> 2, wq = wave & 3;
    const size_t row0 = (size_t)b * 2048; const int q0 = qb * 128; const int NT = 2 * qb + 2; const int myt = 2 * qb + (wq >> 1) + 1;
    __attribute__((address_space(3))) float* wsf = wsf_all + wave * 64;
    const lptr qimg = L + LQ + wave * 4096;
    { const bf16_t* qg = QD + (row0 + q0 + wq * 32 + r32) * 512 + h * 128 + map * 64 + hi * 8; const lptr qw = qimg + hi * 512 + r32 * 16;
#pragma unroll
      for (int i = 0; i < 4; ++i) { const u32x4 v = *(const u32x4*)(qg + 16 * i); *(__attribute__((address_space(3))) u32x4*)(qw + 1024 * i) = v; } }
    const bf16_t* kg = KD + (row0 + lane) * 512 + h * 128 + wave * 8;
    const bf16_t* vg = VD + (row0 + 16 * (wave & 3) + (lane >> 2)) * 512 + h * 128 + (wave >> 2) * 32 + (lane & 3) * 8;
    u32x4 kr0, kr1, vr0, vr1;
#define ATT_LOAD(t) do { const size_t o_ = (size_t)(t) * 64 * 512; kr0 = *(const u32x4*)(kg + o_); kr1 = *(const u32x4*)(kg + o_ + 64); vr0 = *(const u32x4*)(vg + o_); vr1 = *(const u32x4*)(vg + o_ + 64); } while (0)
#define ATT_WRITE(buf) do { const lptr kw_ = L + LK + (buf) * 16384 + wave * 1024 + lane * 16; const lptr vw_ = L + LV + (buf) * 16384 + wave * 1024 + lane * 16; \
        *(__attribute__((address_space(3))) u32x4*)(kw_) = kr0; *(__attribute__((address_space(3))) u32x4*)(kw_ + 8192) = kr1; \
        *(__attribute__((address_space(3))) u32x4*)(vw_) = vr0; *(__attribute__((address_space(3))) u32x4*)(vw_ + 8192) = vr1; } while (0)
    ATT_LOAD(0); ATT_WRITE(0);
    __syncthreads();
    f32x16 O[4] = {}; float m = -INFINITY, l = 0.f;
    for (int t = 0; t < NT; ++t) {
        if (t + 1 < NT) ATT_LOAD(t + 1);
        if (t < myt) { const int buf = t & 1; const int rel0 = 64 * t - (q0 + wq * 32);
            tile_map(O, m, l, L + LK + buf * 16384 + map * 8192, qimg, L + LV + buf * 16384, rel0, 64, btab, wsf, r32, hi, -1); }
        if (t + 1 < NT) ATT_WRITE((t + 1) & 1);
        __syncthreads();
    }
#undef ATT_LOAD
#undef ATT_WRITE
    int lz = 0; asm volatile("" : "+v"(lz));
    l += __shfl_xor(l, 32);
    if (hi == 0) wsf[r32] = (map ? lam : 1.f) / l;
    asm volatile("s_waitcnt lgkmcnt(0)" ::: "memory");
    const lptr xb = L + wq * 16384 + lane * 4 + lz;
#pragma unroll
    for (int r = 0; r < 16; ++r) { const float iv = wsf[crow(r, hi)];
#pragma unroll
        for (int d = 0; d < 4; ++d) O[d][r] *= iv; }
    if (map) {
#pragma unroll
        for (int d = 0; d < 4; ++d)
#pragma unroll
            for (int r = 0; r < 16; ++r) *(__attribute__((address_space(3))) float*)(xb + d * 4096 + r * 256) = O[d][r]; }
    __syncthreads();
    if (!map) {
        float gd[4];
#pragma unroll
        for (int d = 0; d < 4; ++d) gd[d] = g_da[32 * d + r32 + lz] * 0.8f;
        bf16_t* ob = OD + (row0 + q0 + wq * 32 + 4 * hi + lz) * 512 + h * 128 + r32;
#pragma unroll
        for (int r = 0; r < 16; ++r) { float o[4], ss = 0.f;
#pragma unroll
            for (int d = 0; d < 4; ++d) { o[d] = O[d][r] - *(const __attribute__((address_space(3))) float*)(xb + d * 4096 + r * 256); ss += o[d] * o[d]; }
#pragma unroll
            for (int of = 1; of < 32; of <<= 1) ss += __shfl_xor(ss, of);
            const float rs = __builtin_amdgcn_rsqf(ss * (1.f / 128.f) + 1e-6f);
            bf16_t* orow = ob + (size_t)((r & 3) + 8 * (r >> 2)) * 512;
#pragma unroll
            for (int d = 0; d < 4; ++d) orow[32 * d] = f2bf(o[d] * rs * gd[d]); }
    }
    __syncthreads();
}
__device__ __forceinline__ void attn_sample_unit(lptr L, int b, int h, const bf16_t* __restrict__ QD, const bf16_t* __restrict__ KD, const bf16_t* __restrict__ VD, const float* __restrict__ ck, const float* __restrict__ cv,
                                                 bf16_t* __restrict__ OD, const float* __restrict__ g_da, float lam, const __attribute__((address_space(3))) float* btab, __attribute__((address_space(3))) float* wsf_all) {
    const int tid = threadIdx.x, lane = tid & 63, r32 = lane & 31, hi = lane >> 5; const int wave = __builtin_amdgcn_readfirstlane(tid >> 6);
    const int map = wave >> 2, dsel = wave & 3;
    const size_t qrow0 = (size_t)E_MP + (size_t)b * 32;
    __attribute__((address_space(3))) float* wsf = wsf_all + wave * 64;
    const lptr qimg = L + LQ + wave * 4096;
    { const bf16_t* qg = QD + (qrow0 + r32) * 512 + h * 128 + map * 64 + hi * 8; const lptr qw = qimg + hi * 512 + r32 * 16;
#pragma unroll
      for (int i = 0; i < 4; ++i) { const u32x4 v = *(const u32x4*)(qg + 16 * i); *(__attribute__((address_space(3))) u32x4*)(qw + 1024 * i) = v; } }
    const int key0 = tid >> 5, f4 = tid & 31;
    const float* kc = ck + (((size_t)b * 4096 + key0) * 4 + h) * 128 + 4 * f4; const float* vc = cv + (((size_t)b * 4096 + key0) * 4 + h) * 128 + 4 * f4;
    const int kdst = (f4 >> 1) * 1024 + key0 * 16 + (f4 & 1) * 8;
    const int vdst = ((f4 >> 3) * 4 + (key0 >> 4)) * 1024 + (key0 & 15) * 64 + (f4 & 7) * 8;
    f32x4 kf[4], vf[4];
#define SC_LOAD(t) do { _Pragma("unroll") for (int i = 0; i < 4; ++i) { const size_t o_ = ((size_t)(t) * 64 + 16 * i) * 512; kf[i] = *(const f32x4*)(kc + o_); vf[i] = *(const f32x4*)(vc + o_); } } while (0)
#define SC_WRITE(buf) do { _Pragma("unroll") for (int i = 0; i < 4; ++i) { uint2 a_, b_; a_.x = cvtpk(kf[i][0], kf[i][1]); a_.y = cvtpk(kf[i][2], kf[i][3]); b_.x = cvtpk(vf[i][0], vf[i][1]); b_.y = cvtpk(vf[i][2], vf[i][3]); \
        *(__attribute__((address_space(3))) unsigned long long*)(L + LK + (buf) * 16384 + kdst + 256 * i) = (unsigned long long)a_.x | ((unsigned long long)a_.y << 32); \
        *(__attribute__((address_space(3))) unsigned long long*)(L + LV + (buf) * 16384 + vdst + 1024 * i) = (unsigned long long)b_.x | ((unsigned long long)b_.y << 32); } } while (0)
    SC_LOAD(0); SC_WRITE(0);
    __syncthreads();
    f32x16 O[4] = {}; float m = -INFINITY, l = 0.f;
    u32x4 kr0, kr1, vr0, vr1;
    for (int t = 0; t <= 64; ++t) {
        if (t + 1 < 64) SC_LOAD(t + 1);
        else if (t + 1 == 64) {
            const u32x4 z = {0u, 0u, 0u, 0u};
            const bf16_t* kg = KD + (qrow0 + (lane & 31)) * 512 + h * 128 + wave * 8; kr0 = lane < 32 ? *(const u32x4*)kg : z; kr1 = lane < 32 ? *(const u32x4*)(kg + 64) : z;
            const int vrow = 16 * (wave & 3) + (lane >> 2); const bf16_t* vg = VD + (qrow0 + (vrow & 31)) * 512 + h * 128 + (wave >> 2) * 32 + (lane & 3) * 8;
            vr0 = vrow < 32 ? *(const u32x4*)vg : z; vr1 = vrow < 32 ? *(const u32x4*)(vg + 64) : z; }
        { const int buf = t & 1; tile_map(O, m, l, L + LK + buf * 16384 + map * 8192, qimg, L + LV + buf * 16384, 64 * t - 4096, t == 64 ? 32 : 64, btab, wsf, r32, hi, dsel); }
        if (t + 1 < 64) SC_WRITE((t + 1) & 1);
        else if (t + 1 == 64) { const lptr kw_ = L + LK + wave * 1024 + lane * 16; const lptr vw_ = L + LV + wave * 1024 + lane * 16;
            *(__attribute__((address_space(3))) u32x4*)(kw_) = kr0; *(__attribute__((address_space(3))) u32x4*)(kw_ + 8192) = kr1;
            *(__attribute__((address_space(3))) u32x4*)(vw_) = vr0; *(__attribute__((address_space(3))) u32x4*)(vw_ + 8192) = vr1; }
        __syncthreads();
    }
#undef SC_LOAD
#undef SC_WRITE
    int lz = 0; asm volatile("" : "+v"(lz));
    l += __shfl_xor(l, 32);
    if (hi == 0) wsf[r32] = (map ? lam : 1.f) / l;
    asm volatile("s_waitcnt lgkmcnt(0)" ::: "memory");
    const lptr xb = L + dsel * 4096 + lane * 4 + lz;
    __attribute__((address_space(3))) float* pss = (__attribute__((address_space(3))) float*)(L + 16384);
#pragma unroll
    for (int r = 0; r < 16; ++r) O[0][r] *= wsf[crow(r, hi)];
    if (map) {
#pragma unroll
        for (int r = 0; r < 16; ++r) *(__attribute__((address_space(3))) float*)(xb + r * 256) = O[0][r]; }
    __syncthreads();
    float o[16];
    if (!map) {
#pragma unroll
        for (int r = 0; r < 16; ++r) { o[r] = O[0][r] - *(const __attribute__((address_space(3))) float*)(xb + r * 256); float ss = o[r] * o[r];
#pragma unroll
            for (int of = 1; of < 32; of <<= 1) ss += __shfl_xor(ss, of);
            if (r32 == 0) pss[dsel * 32 + crow(r, hi)] = ss; }
    }
    __syncthreads();
    if (!map) {
        const float gd = g_da[32 * dsel + r32 + lz] * 0.8f;
        bf16_t* ob = OD + (qrow0 + 4 * hi + lz) * 512 + h * 128 + 32 * dsel + r32;
#pragma unroll
        for (int r = 0; r < 16; ++r) { const int q = crow(r, hi); const float ss = (pss[q] + pss[32 + q]) + (pss[64 + q] + pss[96 + q]);
            const float rs = __builtin_amdgcn_rsqf(ss * (1.f / 128.f) + 1e-6f);
            ob[(size_t)((r & 3) + 8 * (r >> 2)) * 512] = f2bf(o[r] * rs * gd); }
    }
    __syncthreads();
}
constexpr int RQ = 0, RKA = 16384, RKT = 32768, RVT = 49152, RSB = 65536, RATT = 98304, RPSS = 107520;
__device__ __forceinline__ f32x4 bfx4(unsigned lo, unsigned hi) { return (f32x4){__uint_as_float(lo << 16), __uint_as_float(lo & 0xffff0000u), __uint_as_float(hi << 16), __uint_as_float(hi & 0xffff0000u)}; }
__device__ __forceinline__ void ret_unit(lptr L, int sample, int b, int h, const bf16_t* __restrict__ QR, const bf16_t* __restrict__ KR, const bf16_t* __restrict__ VR, const bf16_t* __restrict__ GRS,
                                         const float* __restrict__ s0, const float* __restrict__ g_rt, bf16_t* __restrict__ ORo, float* __restrict__ sout) {
    typedef __attribute__((address_space(3))) unsigned long long* l64p; typedef __attribute__((address_space(3))) u32x4* l128p; typedef __attribute__((address_space(3))) float* lfp;
    const int tid = threadIdx.x, lane = tid & 63, r32 = lane & 31, hi = lane >> 5; const int wave = __builtin_amdgcn_readfirstlane(tid >> 6);
    const int ib = wave >> 2, jb = wave & 3;
    const int c = sample ? 32 : 64, nch = sample ? 1 : 32;
    const size_t row0 = sample ? (size_t)E_MP + (size_t)b * 32 : (size_t)b * 2048;
    const float lg = __builtin_log2f(1.f - __builtin_amdgcn_exp2f(-5.f - (float)h));
    const float dec_c = __builtin_amdgcn_exp2f(lg * (float)c);
    f32x16 S2[2];
#pragma unroll
    for (int k = 0; k < 2; ++k)
#pragma unroll
        for (int r = 0; r < 16; ++r) S2[k][r] = sample ? s0[(((size_t)b * 4 + h) * 128 + 32 * (2 * ib + k) + crow(r, hi)) * 128 + 32 * jb + r32] : 0.f;
    const lptr sbw = L + RSB + (8 * ib) * 2048 + (32 * jb + r32) * 16 + 8 * hi;
#define RET_WRITE_SB() do { _Pragma("unroll") for (int k = 0; k < 2; ++k) _Pragma("unroll") for (int g = 0; g < 4; ++g) { \
        const unsigned lo_ = cvtpk(S2[k][4 * g], S2[k][4 * g + 1]), hi_ = cvtpk(S2[k][4 * g + 2], S2[k][4 * g + 3]); *(l64p)(sbw + (4 * k + g) * 2048) = (unsigned long long)lo_ | ((unsigned long long)hi_ << 32); } } while (0)
    RET_WRITE_SB();
    const bool cvalid = lane < c; const int trow = 16 * (wave & 3) + (lane >> 2); const bool tvalid = trow < c;
    const size_t coff = (row0 + (cvalid ? lane : 0)) * 512 + h * 128 + wave * 8; const size_t toff = (row0 + (tvalid ? trow : 0)) * 512 + h * 128 + (wave >> 2) * 32 + (lane & 3) * 8;
    const float dk_t = tvalid ? __builtin_amdgcn_exp2f(lg * (float)(c - 1 - trow)) : 0.f;
    u32x4 q0, q1, k0, k1, t0, t1, v0, v1; const u32x4 z4 = {0u, 0u, 0u, 0u};
#define RET_LOAD(ci) do { const size_t o_ = (size_t)(ci) * 64 * 512; q0 = cvalid ? *(const u32x4*)(QR + coff + o_) : z4; q1 = cvalid ? *(const u32x4*)(QR + coff + o_ + 64) : z4; \
        k0 = cvalid ? *(const u32x4*)(KR + coff + o_) : z4; k1 = cvalid ? *(const u32x4*)(KR + coff + o_ + 64) : z4; \
        t0 = *(const u32x4*)(KR + toff + o_); t1 = *(const u32x4*)(KR + toff + o_ + 64); v0 = tvalid ? *(const u32x4*)(VR + toff + o_) : z4; v1 = tvalid ? *(const u32x4*)(VR + toff + o_ + 64) : z4; } while (0)
#define RET_SCALE(t) do { const f32x4 a_ = bfx4(t.x, t.y) * dk_t, b_ = bfx4(t.z, t.w) * dk_t; t.x = cvtpk(a_[0], a_[1]); t.y = cvtpk(a_[2], a_[3]); t.z = cvtpk(b_[0], b_[1]); t.w = cvtpk(b_[2], b_[3]); } while (0)
#define RET_WRITE() do { RET_SCALE(t0); RET_SCALE(t1); const lptr cw_ = L + wave * 1024 + lane * 16; \
        *(l128p)(cw_ + RQ) = q0; *(l128p)(cw_ + RQ + 8192) = q1; *(l128p)(cw_ + RKA) = k0; *(l128p)(cw_ + RKA + 8192) = k1; \
        *(l128p)(cw_ + RKT) = t0; *(l128p)(cw_ + RKT + 8192) = t1; *(l128p)(cw_ + RVT) = v0; *(l128p)(cw_ + RVT + 8192) = v1; } while (0)
    RET_LOAD(0); RET_WRITE();
    __syncthreads();
    const float dqb = lg * (float)(32 * ib + 4 * hi + 1);
    const lptr qa = L + RQ + hi * 1024 + (32 * ib + r32) * 16, sbr = L + RSB + hi * 2048 + (32 * jb + r32) * 16;
    const lptr trb = L + ((lane >> 4) & 1) * 32 + (lane & 3) * 8 + (4 * hi + ((lane & 15) >> 2)) * 64;
    const lptr attr = L + RATT + (32 * ib + r32) * 144 + 8 * hi;
    const float grt = g_rt[32 * jb + r32];
    for (int ci = 0; ci < nch; ++ci) {
        if (ci + 1 < nch) RET_LOAD(ci + 1);
        int lz = 0; asm volatile("" : "+v"(lz));
        unsigned short gr[16];
#pragma unroll
        for (int r = 0; r < 16; ++r) { const int tok = 32 * ib + crow(r, hi); gr[r] = GRS[(row0 + (size_t)ci * 64 + (tok < c ? tok : 0)) * 512 + h * 128 + 32 * jb + r32]; }
        f32x16 oS = {};
#pragma unroll
        for (int s = 0; s < 8; ++s) { const bf16x8 a_ = *(const __attribute__((address_space(3))) bf16x8*)(qa + 2 * s * 1024), b_ = *(const __attribute__((address_space(3))) bf16x8*)(sbr + 2 * s * 2048);
            oS = __builtin_amdgcn_mfma_f32_32x32x16_bf16(a_, b_, oS, 0, 0, 0); }
        if (jb < 2 && !(ib == 0 && jb == 1)) {
            f32x16 at = {}; const lptr ka = L + RKA + hi * 1024 + (32 * jb + r32) * 16;
#pragma unroll
            for (int s = 0; s < 8; ++s) { const bf16x8 a_ = *(const __attribute__((address_space(3))) bf16x8*)(ka + 2 * s * 1024), b_ = *(const __attribute__((address_space(3))) bf16x8*)(qa + 2 * s * 1024);
                at = __builtin_amdgcn_mfma_f32_32x32x16_bf16(a_, b_, at, 0, 0, 0); }
            const int i = 32 * ib + r32;
#pragma unroll
            for (int g = 0; g < 4; ++g) { float w_[4];
#pragma unroll
                for (int e = 0; e < 4; ++e) { const int j = 32 * jb + 8 * g + 4 * hi + e; w_[e] = i >= j ? at[4 * g + e] * __builtin_amdgcn_exp2f(lg * (float)(i - j + lz)) : 0.f; }
                *(l64p)(L + RATT + i * 144 + (32 * jb + 8 * g + 4 * hi) * 2) = (unsigned long long)cvtpk(w_[0], w_[1]) | ((unsigned long long)cvtpk(w_[2], w_[3]) << 32); }
        }
        __syncthreads();
        f32x16 oI = {};
#pragma unroll
        for (int ks = 0; ks < 4; ++ks) { if (ib == 0 && ks >= 2) break;
            const s16x4 a0 = *(const __attribute__((address_space(3))) s16x4*)(attr + 32 * ks), a1 = *(const __attribute__((address_space(3))) s16x4*)(attr + 32 * ks + 16);
            const s16x4 lo = vtr(trb + RVT + jb * 4096 + ks * 1024), hh = vtr(trb + RVT + jb * 4096 + ks * 1024 + 512);
            const bf16x8 af = {a0[0], a0[1], a0[2], a0[3], a1[0], a1[1], a1[2], a1[3]}, vf = {lo[0], lo[1], lo[2], lo[3], hh[0], hh[1], hh[2], hh[3]};
            oI = __builtin_amdgcn_mfma_f32_32x32x16_bf16(af, vf, oI, 0, 0, 0); }
#pragma unroll
        for (int k = 0; k < 2; ++k) {
#pragma unroll
            for (int r = 0; r < 16; ++r) S2[k][r] *= dec_c;
#pragma unroll
            for (int ks = 0; ks < 4; ++ks) {
                const s16x4 kl = vtr(trb + RKT + (2 * ib + k) * 4096 + ks * 1024), kh = vtr(trb + RKT + (2 * ib + k) * 4096 + ks * 1024 + 512);
                const s16x4 lo = vtr(trb + RVT + jb * 4096 + ks * 1024), hh = vtr(trb + RVT + jb * 4096 + ks * 1024 + 512);
                const bf16x8 kf = {kl[0], kl[1], kl[2], kl[3], kh[0], kh[1], kh[2], kh[3]}, vf = {lo[0], lo[1], lo[2], lo[3], hh[0], hh[1], hh[2], hh[3]};
                S2[k] = __builtin_amdgcn_mfma_f32_32x32x16_bf16(kf, vf, S2[k], 0, 0, 0); } }
        RET_WRITE_SB();
        float o[16];
#pragma unroll
        for (int r = 0; r < 16; ++r) { o[r] = oI[r] + oS[r] * __builtin_amdgcn_exp2f(dqb + lg * (float)((r & 3) + 8 * (r >> 2) + lz)); float ss = o[r] * o[r];
#pragma unroll
            for (int of = 1; of < 32; of <<= 1) ss += __shfl_xor(ss, of);
            if (r32 == 0) *(lfp)(L + RPSS + (jb * 64 + 32 * ib + crow(r, hi)) * 4) = ss; }
        __syncthreads();
        { bf16_t* ob = ORo + (row0 + (size_t)ci * 64 + 32 * ib + 4 * hi) * 512 + h * 128 + 32 * jb + r32; const lfp ps = (lfp)(L + RPSS + (32 * ib + 4 * hi) * 4);
#pragma unroll
          for (int r = 0; r < 16; ++r) { const int to = (r & 3) + 8 * (r >> 2); const float tot = (ps[to] + ps[64 + to]) + (ps[128 + to] + ps[192 + to]);
              const float rs = __builtin_amdgcn_rsqf(tot * (1.f / 128.f) + 1e-6f);
              if (32 * ib + 4 * hi + to < c) ob[(size_t)to * 512] = f2bf(o[r] * rs * grt * bf2f(gr[r])); } }
        if (ci + 1 < nch) RET_WRITE();
        __syncthreads();
    }
#undef RET_LOAD
#undef RET_SCALE
#undef RET_WRITE
#undef RET_WRITE_SB
#pragma unroll
    for (int k = 0; k < 2; ++k)
#pragma unroll
        for (int r = 0; r < 16; ++r) sout[(((size_t)b * 4 + h) * 128 + 32 * (2 * ib + k) + crow(r, hi)) * 128 + 32 * jb + r32] = S2[k][r];
}
}

constexpr int NWAVES = 8;
constexpr int RING_BYTES = 131072, LDSCTL_OFF = RING_BYTES, MISC_OFF = LDSCTL_OFF + 320, LDS_BYTES = 147456;
constexpr size_t al256(size_t x) { return (x + 255) & ~(size_t)255; }
constexpr size_t WS_CTL = 0, CTL_ZERO_BYTES = 1u << 20;
constexpr size_t WS_BT_IN = CTL_ZERO_BYTES;
constexpr size_t WS_BT_BD = WS_BT_IN + (size_t)DIN * D * 2;
constexpr size_t WS_BT_BR = WS_BT_BD + (size_t)D * 512 * 2;
constexpr size_t WS_BT_O = WS_BT_BR + (size_t)D * 512 * 2;
constexpr size_t WS_BT_GU = WS_BT_O + (size_t)D * D * 2;
constexpr size_t WS_BT_D = WS_BT_GU + (size_t)DIN * D * 2;
constexpr size_t WS_BT_PE = WS_BT_D + (size_t)D * DFF * 2;
constexpr size_t WS_BT_PG = WS_BT_PE + (size_t)D * PE * 2;
constexpr size_t WS_ROT = WS_BT_PG + (size_t)D * D * 2;
constexpr size_t WS_XN = al256(WS_ROT + (size_t)2080 * 64 * 8);
constexpr size_t WS_PEB = WS_XN + (size_t)M * D * 2;
constexpr size_t WS_REGB = WS_PEB + (size_t)M * PE * 2;
constexpr size_t WS_OD = WS_REGB + (size_t)M * DIN * 2;
constexpr size_t WS_OR = WS_OD + (size_t)M * 512 * 2;
constexpr size_t WS_H1 = WS_OR + (size_t)M * 512 * 2;
constexpr size_t WS_REGA = WS_H1 + (size_t)M * D * 4;
constexpr size_t WS_END = WS_REGA + (size_t)M * DIN * 2;

#define GAS __attribute__((address_space(1)))
#define LAS __attribute__((address_space(3)))
typedef unsigned v4u __attribute__((ext_vector_type(4)));
typedef GAS unsigned gu32;
#define RLX_AGENT __ATOMIC_RELAXED, __HIP_MEMORY_SCOPE_AGENT
#define LDS_WAIT() asm volatile("s_waitcnt lgkmcnt(0)" ::: "memory")
#define VM_WAIT() asm volatile("s_waitcnt vmcnt(0)" ::: "memory")
__device__ __forceinline__ unsigned pk2(float lo, float hi) { return (unsigned)f2bf(lo) | ((unsigned)f2bf(hi) << 16); }

struct Args { const float* in[31]; float* out; unsigned char* ws; int ph_lo, ph_hi, li, pad; };

__device__ __forceinline__ void p0_transpose_item(const float* W, int K, int N, bf16_t* WT, int dst_row0, const float* gk, LAS float* scr, int k0, int n0, int lane) {
#pragma unroll 8
    for (int i = 0; i < 32; ++i) { const int kk = 2 * i + (lane >> 5); float w = W[(size_t)(k0 + kk) * N + n0 + (lane & 31)]; if (gk) w *= gk[k0 + kk]; scr[kk * 33 + (lane & 31)] = w; }
    LDS_WAIT(); asm volatile("" ::: "memory");
    const int c = lane & 7;
#pragma unroll
    for (int j = 0; j < 4; ++j) { const int n = (lane >> 3) + 8 * j; const LAS float* s = scr + (8 * c) * 33 + n;
        v4u o; o.x = pk2(s[0 * 33], s[1 * 33]); o.y = pk2(s[2 * 33], s[3 * 33]); o.z = pk2(s[4 * 33], s[5 * 33]); o.w = pk2(s[6 * 33], s[7 * 33]);
        *(v4u*)(WT + (size_t)(dst_row0 + n) * K + k0 + 8 * c) = o; }
    LDS_WAIT(); asm volatile("" ::: "memory");
}
__device__ __forceinline__ int btin_dst(int nb) {
    const int tile = nb >> 3, o = nb & 7; int ct;
    if (tile < 4) ct = 128 * (o & 1) + 32 * (o >> 1);
    else if (tile >= 6 && tile < 10) ct = 128 * ((o >> 1) & 1) + 32 * (2 * (o >> 2) + (o & 1));
    else ct = 32 * o;
    return tile * 256 + ct;
}
__device__ __forceinline__ float wave_sum(float v) {
#pragma unroll
    for (int o = 1; o < 64; o <<= 1) v += __shfl_xor(v, o);
    return v;
}

constexpr int CW_BAR = 4096;
#define XB_TMO      128
#define XB_XCNT(j)  (256  + 64 * (j))
#define XB_XSUB(j)  (1280 + 64 * (j))
#define XB_XGEN(j)  (2304 + 64 * (j))
#define XB_TOP      3328
#define XB_TOPGEN   3392
#define XCD_BAR_WORDS 3456
#define XB_SPIN_CAP (1u << 18)

__device__ __forceinline__ unsigned xb_ld(unsigned* p)              { return __hip_atomic_load(p, __ATOMIC_RELAXED, __HIP_MEMORY_SCOPE_AGENT); }
__device__ __forceinline__ unsigned xb_add(unsigned* p, unsigned v) { return __hip_atomic_fetch_add(p, v, __ATOMIC_RELAXED, __HIP_MEMORY_SCOPE_AGENT); }
__device__ __forceinline__ unsigned xb_xcc_id() { return (unsigned)__builtin_amdgcn_s_getreg((3 << 11) | 20) & 0xFu; }
#define XB_SPIN(cond, bar) do { unsigned _sp = 0; while (cond) { __builtin_amdgcn_s_sleep(1); \
    if ((++_sp & 255u) == 0u) { if (xb_ld(&(bar)[XB_TMO])) break; if (_sp > XB_SPIN_CAP) { atomicAdd(&(bar)[XB_TMO], 1u); break; } } } } while (0)

struct XcdBarrier {
    unsigned* bar; unsigned x;
    volatile LAS unsigned* st;
};

__device__ __forceinline__ XcdBarrier xcd_barrier_post(unsigned* bar, volatile LAS unsigned* st) {
    XcdBarrier b; b.bar = bar; b.x = xb_xcc_id(); b.st = st;
    if (threadIdx.x == 0) (void)xb_add(&bar[XB_XCNT(b.x)], 1u);
    return b;
}
__device__ __forceinline__ void xcd_barrier_complete(unsigned* bar, unsigned x, unsigned& nloc, unsigned& nx) {
    const unsigned G = gridDim.x * gridDim.y * gridDim.z;
    unsigned sum, cnt, mine, sp = 0u;
    for (;;) {
        sum = 0u; cnt = 0u; mine = 0u;
#pragma unroll
        for (unsigned j = 0; j < 16; ++j) { const unsigned c = xb_ld(&bar[XB_XCNT(j)]); sum += c; cnt += (c > 0u) ? 1u : 0u; mine = (j == x) ? c : mine; }
        if (sum == G) break;
        __builtin_amdgcn_s_sleep(1);
        if ((++sp & 255u) == 0u) { if (xb_ld(&bar[XB_TMO])) break; if (sp > XB_SPIN_CAP) { atomicAdd(&bar[XB_TMO], 1u); break; } }
    }
    nloc = mine > 0u ? mine : 1u; nx = cnt > 0u ? cnt : 1u;
}

__device__ __forceinline__ void xcd_barrier(const XcdBarrier& b) {
    asm volatile("s_waitcnt vmcnt(0)" ::: "memory");
    __syncthreads();
    if (threadIdx.x == 0) {
        unsigned* bar = b.bar;
        __builtin_amdgcn_s_waitcnt(0);
        unsigned nloc = b.st[0], nx = b.st[1];
        if (nloc == 0u) { xcd_barrier_complete(bar, b.x, nloc, nx); b.st[0] = nloc; b.st[1] = nx; }
        const unsigned old = xb_add(&bar[XB_XSUB(b.x)], 1u);
        const unsigned gen = old / nloc;
        if (old + 1u == (gen + 1u) * nloc) {
            __builtin_amdgcn_fence(__ATOMIC_RELEASE, "agent");
            asm volatile("s_waitcnt vmcnt(0)" ::: "memory");
            const unsigned og = xb_add(&bar[XB_TOP], 1u);
            const unsigned tg = og / nx;
            if (og + 1u == (tg + 1u) * nx) xb_add(&bar[XB_TOPGEN], 1u);
            else XB_SPIN(xb_ld(&bar[XB_TOPGEN]) == tg, bar);
            __builtin_amdgcn_fence(__ATOMIC_ACQUIRE, "agent");
            xb_add(&bar[XB_XGEN(b.x)], 1u);
            asm volatile("s_waitcnt vmcnt(0)" ::: "memory");
        } else {
            XB_SPIN(xb_ld(&bar[XB_XGEN(b.x)]) == gen, bar);
            __builtin_amdgcn_fence(__ATOMIC_ACQUIRE, "agent");
            asm volatile("s_waitcnt vmcnt(0)" ::: "memory");
        }
    }
    __syncthreads();
}

__global__ void __launch_bounds__(NWAVES * 64, 2) mk_fwd(Args args) {
    extern __shared__ __attribute__((aligned(16))) unsigned char lds[];
    LAS unsigned char* L = (LAS unsigned char*)lds;
    const int tid = threadIdx.x, lane = tid & 63, wave = __builtin_amdgcn_readfirstlane(tid >> 6);
    const int G = gridDim.x, bx = blockIdx.x; const int vcu = (G % 8 == 0) ? (bx % 8) * (G / 8) + bx / 8 : bx;
    unsigned char* ws = args.ws;
    const int lo = args.ph_lo, hi = args.ph_hi;
#define IN(k) (lo <= (k) && (k) < hi)
#define BOTH(k, k2) (IN(k) && IN(k2))
    for (int u_ = tid; u_ < (LDS_BYTES - LDSCTL_OFF) / 4; u_ += NWAVES * 64) ((LAS unsigned*)(L + LDSCTL_OFF))[u_] = 0u;
    __syncthreads();
    XcdBarrier bar = xcd_barrier_post((unsigned*)(ws + WS_CTL) + CW_BAR + args.li * XCD_BAR_WORDS, (volatile LAS unsigned*)(L + MISC_OFF) + 8);
#define GRID_BAR() xcd_barrier(bar)
    const float* x_p = args.in[0]; const float* x_s = args.in[1]; const float* p_p = args.in[2]; const float* p_s = args.in[3];
    bf16_t* XN = (bf16_t*)(ws + WS_XN); bf16_t* PEB = (bf16_t*)(ws + WS_PEB); float* ROT = (float*)(ws + WS_ROT);
    bf16_t* QD = (bf16_t*)(ws + WS_REGB); bf16_t* KD = QD + (size_t)M * 512; bf16_t* VD = KD + (size_t)M * 512; bf16_t* QR = VD + (size_t)M * 512; bf16_t* KR = QR + (size_t)M * 512;
    bf16_t* VR = KR + (size_t)M * 512; bf16_t* GRS = VR + (size_t)M * 512; bf16_t* GD = GRS + (size_t)M * 512; bf16_t* GT = GD + (size_t)M * D;
    float* out = args.out;
    float* k_p = out + (size_t)M * D; float* v_p = k_p + (size_t)MP * 512; float* r_p = v_p + (size_t)MP * 512; float* c_p = r_p + (size_t)16 * 4 * 128 * 128;
    float* k_s = c_p + (size_t)16 * 2 * DFF; float* v_s = k_s + (size_t)MS * 512;

    if (IN(0)) {
        LAS float* scr = (LAS float*)(L + wave * 16384);
        const int gw = vcu * NWAVES + wave, NGW = G * NWAVES;
        const float* w_in = args.in[10]; const float* w_bd = args.in[19]; const float* w_br = args.in[20]; const float* w_o = args.in[21]; const float* g_ffn = args.in[22];
        const float* w_g = args.in[23]; const float* w_u = args.in[24]; const float* w_d = args.in[27]; const float* g_pe = args.in[28]; const float* w_pe = args.in[29]; const float* w_pg = args.in[30];
        constexpr int I_IN = 16 * 176, I_BD = 8 * 32, I_O = 16 * 32, I_G = 16 * 88, I_D = 44 * 32, I_PE = 4 * 32;
        constexpr int NITEMS = I_IN + 2 * I_BD + I_O + 2 * I_G + I_D + I_PE + I_O;
        for (int it = gw; it < NITEMS; it += NGW) {
            int r = it;
            if (r < I_IN) { const int kb = r / 176, nb = r % 176; p0_transpose_item(w_in, D, DIN, (bf16_t*)(ws + WS_BT_IN), btin_dst(nb), nullptr, scr, 64 * kb, 32 * nb, lane); continue; } r -= I_IN;
            if (r < I_BD) { const int kb = r / 32, nb = r % 32; p0_transpose_item(w_bd, 512, D, (bf16_t*)(ws + WS_BT_BD), 32 * nb, nullptr, scr, 64 * kb, 32 * nb, lane); continue; } r -= I_BD;
            if (r < I_BD) { const int kb = r / 32, nb = r % 32; p0_transpose_item(w_br, 512, D, (bf16_t*)(ws + WS_BT_BR), 32 * nb, nullptr, scr, 64 * kb, 32 * nb, lane); continue; } r -= I_BD;
            if (r < I_O) { const int kb = r / 32, nb = r % 32; p0_transpose_item(w_o, D, D, (bf16_t*)(ws + WS_BT_O), 32 * nb, nullptr, scr, 64 * kb, 32 * nb, lane); continue; } r -= I_O;
            if (r < I_G) { const int kb = r / 88, nb = r % 88; p0_transpose_item(w_g, D, DFF, (bf16_t*)(ws + WS_BT_GU), 256 * (nb >> 2) + 32 * (nb & 3), g_ffn, scr, 64 * kb, 32 * nb, lane); continue; } r -= I_G;
            if (r < I_G) { const int kb = r / 88, nb = r % 88; p0_transpose_item(w_u, D, DFF, (bf16_t*)(ws + WS_BT_GU), 256 * (nb >> 2) + 128 + 32 * (nb & 3), g_ffn, scr, 64 * kb, 32 * nb, lane); continue; } r -= I_G;
            if (r < I_D) { const int kb = r / 32, nb = r % 32; p0_transpose_item(w_d, DFF, D, (bf16_t*)(ws + WS_BT_D), 32 * nb, nullptr, scr, 64 * kb, 32 * nb, lane); continue; } r -= I_D;
            if (r < I_PE) { const int kb = r / 32, nb = r % 32; p0_transpose_item(w_pe, PE, D, (bf16_t*)(ws + WS_BT_PE), 32 * nb, nullptr, scr, 64 * kb, 32 * nb, lane); continue; } r -= I_PE;
            { const int kb = r / 32, nb = r % 32; p0_transpose_item(w_pg, D, D, (bf16_t*)(ws + WS_BT_PG), 32 * nb, g_pe, scr, 64 * kb, 32 * nb, lane); }
        }
        const float* g_mix = args.in[9];
        for (int m = gw; m < M; m += NGW) {
            const float* xr = m < MP ? x_p + (size_t)m * D : x_s + (size_t)(m - MP) * D;
            f32x4 v[4]; float ss = 0.f;
#pragma unroll
            for (int j = 0; j < 4; ++j) { v[j] = ((const f32x4*)xr)[lane + 64 * j]; ss += (v[j][0] * v[j][0] + v[j][1] * v[j][1]) + (v[j][2] * v[j][2] + v[j][3] * v[j][3]); }
            const float rstd = rsqrtf(wave_sum(ss) * (1.f / D) + EPS);
#pragma unroll
            for (int j = 0; j < 4; ++j) { const f32x4 gv = ((const f32x4*)g_mix)[lane + 64 * j]; const f32x4 o = v[j] * rstd * gv;
                uint2 w; w.x = pk2(o[0], o[1]); w.y = pk2(o[2], o[3]); ((uint2*)(XN + (size_t)m * D))[lane + 64 * j] = w; }
        }
        for (size_t i = (size_t)gw * 64 + lane; i < (size_t)M * PE / 4; i += (size_t)NGW * 64) {
            const f32x4 v = i < (size_t)MP * PE / 4 ? ((const f32x4*)p_p)[i] : ((const f32x4*)p_s)[i - (size_t)MP * PE / 4];
            uint2 w; w.x = pk2(v[0], v[1]); w.y = pk2(v[2], v[3]); ((uint2*)PEB)[i] = w; }
        for (int i = gw * 64 + lane; i < 2080 * 64; i += NGW * 64) { const int pidx = i >> 6, d = i & 63; const int pos = pidx < 2048 ? pidx : PAST + (pidx - 2048);
            const float inv = powf(10000.f, -(float)d / 64.f); const float ang = (float)pos * inv; float sn, cs; sincosf(ang, &sn, &cs); ROT[2 * i] = cs; ROT[2 * i + 1] = sn; }
    }
    if (BOTH(0, 1)) GRID_BAR();
    if (IN(1)) {
        pg8::Gemm g{XN, (const bf16_t*)(ws + WS_BT_IN), M, DIN, D}; pg8::StaticOrder S; S.init(M, DIN, G, bx);
        pg8::EpiIn E{QD, KD, VD, QR, KR, VR, GRS, GD, GT, k_p, k_s, v_p, v_s, args.in[11], args.in[12], ROT};
        pg8::gemm_phase<pg8::EpiIn, pg8::StaticOrder, true, true>(L, g, S, E);
    }
    bf16_t* OD = (bf16_t*)(ws + WS_OD); bf16_t* ORb = (bf16_t*)(ws + WS_OR);
    float* T1 = (float*)(ws + WS_REGB); bf16_t* MIX = (bf16_t*)(ws + WS_REGB + (size_t)M * D * 4);
    bf16_t* ACT = (bf16_t*)(ws + WS_REGB); float* HEADP = (float*)(ws + WS_REGB + (size_t)200 * 1048576); float* HEADU = HEADP + (size_t)512 * 2 * DFF; float* TAIL = HEADU + (size_t)512 * 2 * DFF;
    float* H1 = (float*)(ws + WS_H1); float* TPE = H1; float* SS1 = (float*)(ws + WS_OD); float* SS2 = SS1 + (size_t)1048576;
    float* y = out; float* c_s = v_s + (size_t)MS * 512 + (size_t)32 * 4 * 128 * 128;
    LAS float* tab = (LAS float*)(L + LDSCTL_OFF + 1024);
    if (BOTH(1, 2)) GRID_BAR();
    if (IN(2)) {
        LAS float* btab = (LAS float*)(L + LDSCTL_OFF + 2048); LAS float* wsf = (LAS float*)(L + LDSCTL_OFF + 3328);
        float lam; { float a_ = 0.f, c_ = 0.f; for (int i = 0; i < 64; ++i) { a_ += args.in[13][i] * args.in[14][i]; c_ += args.in[15][i] * args.in[16][i]; } lam = __expf(a_) - __expf(c_) + LAM_INIT; }
        for (int k = 0; k < 4; ++k) {
            const int pr = bx * 2 + (k >> 1); const int bh = pr >> 3, s = pr & 7; const int qb = (k & 1) ? s : 15 - s; const int b = bh >> 2, h = bh & 3;
            if (bx < 256) {
                if (tid < 288) btab[tid] = args.in[8][t5_bucket(tid - 223) * 4 + h];
                att::attn_prompt_unit(L, b, h, qb, QD, KD, VD, OD, args.in[17], lam, btab, wsf);
            }
        }
    }
    if (IN(2) && bx < 128) {
        LAS float* btab = (LAS float*)(L + LDSCTL_OFF + 2048); LAS float* wsf = (LAS float*)(L + LDSCTL_OFF + 3328);
        float lam; { float a_ = 0.f, c_ = 0.f; for (int i = 0; i < 64; ++i) { a_ += args.in[13][i] * args.in[14][i]; c_ += args.in[15][i] * args.in[16][i]; } lam = __expf(a_) - __expf(c_) + LAM_INIT; }
        const int b = bx >> 2, h = bx & 3;
        if (tid < 288) btab[tid] = args.in[8][t5_bucket(tid - 223) * 4 + h];
        att::attn_sample_unit(L, b, h, QD, KD, VD, args.in[4], args.in[5], OD, args.in[17], lam, btab, wsf);
    }
    if (IN(2)) {
        float* r_s = v_s + (size_t)MS * 512;
        if (bx >= 192 && bx < 256) { const int u_ = bx - 192; att::ret_unit(L, 0, u_ >> 2, u_ & 3, QR, KR, VR, GRS, args.in[6], args.in[18], ORb, r_p); }
        else if (bx >= 64 && bx < 192) { const int u_ = bx - 64; att::ret_unit(L, 1, u_ >> 2, u_ & 3, QR, KR, VR, GRS, args.in[6], args.in[18], ORb, r_s); }
    }
    if (BOTH(2, 3)) GRID_BAR();
    if (IN(3)) {
        { pg8::Gemm g{OD, (const bf16_t*)(ws + WS_BT_BD), M, D, 512}; pg8::StaticOrder S; S.init(M, D, G, bx); pg8::EpiGateT1 E{GD, T1};
          pg8::gemm_phase<pg8::EpiGateT1, pg8::StaticOrder, true, true>(L, g, S, E); }
        { pg8::Gemm g{ORb, (const bf16_t*)(ws + WS_BT_BR), M, D, 512}; pg8::StaticOrder S; S.init(M, D, G, bx); pg8::EpiMixOut E{GT, T1, MIX};
          pg8::gemm_phase<pg8::EpiMixOut, pg8::StaticOrder, true, true>(L, g, S, E); }
    }
    if (BOTH(3, 4)) GRID_BAR();
    if (IN(4)) {
        pg8::Gemm g{MIX, (const bf16_t*)(ws + WS_BT_O), M, D, D}; pg8::StaticOrder S; S.init(M, D, G, bx);
        pg8::EpiResNorm E{x_p, x_s, H1, XN, SS1};
        pg8::gemm_phase<pg8::EpiResNorm, pg8::StaticOrder, true, true>(L, g, S, E);
    }
    if (BOTH(4, 5)) GRID_BAR();
    if (IN(5)) {
        pg8::Gemm g{XN, (const bf16_t*)(ws + WS_BT_GU), M, DIN, D}; pg8::StaticOrder S; S.init(M, DIN, G, bx);
        pg8::EpiGU E{SS1, args.in[7], args.in[25], args.in[26], ACT, HEADP, HEADU, TAIL, c_p, c_s, tab};
        pg8::gemm_phase<pg8::EpiGU, pg8::StaticOrder, true, true>(L, g, S, E);
    }
    if (BOTH(5, 6)) GRID_BAR();
    if (IN(6)) {
        const float* cw = args.in[25];
        for (int i = bx * (NWAVES * 64) + tid; i < 512 * 2 * (DFF / 4); i += G * NWAVES * 64) {
            const int j4 = i % (DFF / 4), rr = (i / (DFF / 4)) & 1, grp = i / (2 * (DFF / 4));
            const size_t o = ((size_t)grp * 2 + rr) * DFF + 4 * j4;
            f32x4 gc = *(const f32x4*)(HEADP + o); const f32x4 uu = *(const f32x4*)(HEADU + o);
            if (grp & 31) { const f32x4 t0 = *(const f32x4*)(TAIL + ((size_t)(grp - 1) * 2) * DFF + 4 * j4), t1 = *(const f32x4*)(TAIL + ((size_t)(grp - 1) * 2 + 1) * DFF + 4 * j4);
                const f32x4 w0 = *(const f32x4*)(cw + 4 * j4), w1 = *(const f32x4*)(cw + DFF + 4 * j4);
                gc = rr == 0 ? gc + w0 * t0 + w1 * t1 : gc + w0 * t1; }
            f32x4 a;
#pragma unroll
            for (int k = 0; k < 4; ++k) a[k] = pg8::gelu_t(gc[k]) * uu[k];
            uint2 w; w.x = pg8::cvtpk(a[0], a[1]); w.y = pg8::cvtpk(a[2], a[3]);
            *(uint2*)(ACT + (size_t)(grp * 64 + rr) * DFF + 4 * j4) = w;
        }
    }
    if (BOTH(6, 7)) GRID_BAR();
    if (IN(7)) {
        pg8::Gemm g{ACT, (const bf16_t*)(ws + WS_BT_D), M, D, DFF}; pg8::StaticOrder S; S.init(M, D, G, bx);
        pg8::EpiResNorm E{H1, H1 + (size_t)MP * D, y, XN, SS2};
        pg8::gemm_phase<pg8::EpiResNorm, pg8::StaticOrder, true, true>(L, g, S, E);
    }
    if (BOTH(7, 8)) GRID_BAR();
    if (IN(8)) {
        { int kpe = PE; asm volatile("" : "+s"(kpe));
          pg8::Gemm g{PEB, (const bf16_t*)(ws + WS_BT_PE), M, D, kpe}; pg8::StaticOrder S; S.init(M, D, G, bx); pg8::EpiStoreF32 E{TPE};
          pg8::gemm_phase<pg8::EpiStoreF32, pg8::StaticOrder, true, true>(L, g, S, E); }
        { pg8::Gemm g{XN, (const bf16_t*)(ws + WS_BT_PG), M, D, D}; pg8::StaticOrder S; S.init(M, D, G, bx); pg8::EpiFinalY E{SS2, TPE, y, tab};
          pg8::gemm_phase<pg8::EpiFinalY, pg8::StaticOrder, true, true>(L, g, S, E); }
    }
#undef IN
#undef BOTH
#undef GRID_BAR
}
extern "C" void kernel_launch(void* const* d_in, const int* in_sizes, int n_in, void* d_out, int out_size, void* d_ws, size_t ws_size, hipStream_t stream) {
    const float* x_p = (const float*)d_in[0]; const float* x_s = (const float*)d_in[1];
    const float* cache_k = (const float*)d_in[4]; const float* cache_v = (const float*)d_in[5]; const float* state_ret = (const float*)d_in[6]; const float* state_conv = (const float*)d_in[7];
    const float* rel_bias = (const float*)d_in[8];
    const float* lq1 = (const float*)d_in[13]; const float* lk1 = (const float*)d_in[14]; const float* lq2 = (const float*)d_in[15];
    const float* lk2 = (const float*)d_in[16]; const float* g_da = (const float*)d_in[17]; const float* g_rt = (const float*)d_in[18]; const float* w_bd = (const float*)d_in[19];
    const float* w_br = (const float*)d_in[20]; const float* w_o = (const float*)d_in[21]; const float* g_ffn = (const float*)d_in[22]; const float* w_g = (const float*)d_in[23];
    const float* w_u = (const float*)d_in[24]; const float* conv_w = (const float*)d_in[25]; const float* conv_b = (const float*)d_in[26]; const float* w_d = (const float*)d_in[27];
    const float* g_pe = (const float*)d_in[28]; const float* w_pe = (const float*)d_in[29]; const float* w_pg = (const float*)d_in[30];
    float* out = (float*)d_out;
    float* y = out; float* k_p = out + (size_t)M * D; float* v_p = k_p + (size_t)MP * 512; float* r_p = v_p + (size_t)MP * 512; float* c_p = r_p + (size_t)16 * 4 * 128 * 128;
    float* k_s = c_p + (size_t)16 * 2 * DFF; float* v_s = k_s + (size_t)MS * 512; float* r_s = v_s + (size_t)MS * 512; float* c_s = r_s + (size_t)32 * 4 * 128 * 128;
    (void)k_p; (void)k_s; (void)v_p; (void)v_s;
    static int grid = 0;
    if (grid == 0) {
        if (ws_size < WS_END) { fprintf(stderr, "kernel_launch: workspace too small: need %zu have %zu\n", (size_t)WS_END, ws_size); grid = -1; return; }
        int dev = 0, cus = 0; hipGetDevice(&dev); hipDeviceGetAttribute(&cus, hipDeviceAttributeMultiprocessorCount, dev);
        if (hipFuncSetAttribute((const void*)mk_fwd, hipFuncAttributeMaxDynamicSharedMemorySize, LDS_BYTES) != hipSuccess) { fprintf(stderr, "kernel_launch: hipFuncSetAttribute failed\n"); grid = -1; return; }
        grid = cus;
    }
    if (grid < 0) return;
    unsigned char* ws = (unsigned char*)d_ws;
    hipMemsetAsync(ws + WS_CTL, 0, CTL_ZERO_BYTES, stream);
    Args a; memset(&a, 0, sizeof(a));
    for (int i = 0; i < 31; ++i) a.in[i] = (const float*)d_in[i];
    a.out = out; a.ws = ws;
    a.li = 0; a.ph_lo = 0; a.ph_hi = 9; hipLaunchKernelGGL(mk_fwd, dim3(grid), dim3(NWAVES * 64), LDS_BYTES, stream, a);
}
```

```cpp
#include <hip/hip_runtime.h>
#include <stdint.h>
#include <cstdio>

typedef unsigned short bf16_t;
typedef short bf16x8 __attribute__((ext_vector_type(8)));
typedef float f32x4 __attribute__((ext_vector_type(4)));

constexpr int D = 1024, MP = 32768, MS = 1024, M = MP + MS, TP = 2048, TS = 32, PAST = 4096;
constexpr int DIN = 5632, DFF = 2816, PE = 256;
constexpr float EPS = 1e-6f;
constexpr float LAM_INIT = 0.2f;

__device__ __forceinline__ unsigned short f2bf(float f) { unsigned u = __float_as_uint(f); return (unsigned short)((u + 0x7fffu + ((u >> 16) & 1u)) >> 16); }
__device__ __forceinline__ float bf2f(unsigned short b) { return __uint_as_float(((unsigned)b) << 16); }
__device__ __forceinline__ float sigmoidf_(float x) { return 1.f / (1.f + __expf(-x)); }
__device__ __forceinline__ float gelu_tanh(float x) { const float u = 0.7978845608028654f * (x + 0.044715f * x * x * x); return 0.5f * x * (1.f + tanhf(u)); }
__device__ __forceinline__ void row_info(int m, int& b, int& t, int& pos) {
    if (m < MP) { b = m >> 11; t = m & 2047; pos = t; } else { const int ms = m - MP; b = ms >> 5; t = ms & 31; pos = PAST + t; }
}
__device__ __forceinline__ int t5_bucket(int rel) {
    const int ret = rel > 0 ? 16 : 0; const int n = rel < 0 ? -rel : rel;
    int v;
    if (n < 8) v = n; else if (n < 12) v = 8; else if (n < 16) v = 9; else if (n < 23) v = 10; else if (n < 32) v = 11; else if (n < 46) v = 12; else if (n < 64) v = 13; else if (n < 91) v = 14; else v = 15;
    return ret + v;
}

__global__ void __launch_bounds__(256) k_rmsnorm(const float* __restrict__ xp, const float* __restrict__ xs, const float* __restrict__ g, bf16_t* __restrict__ out) {
    const int row = (blockIdx.x * 256 + threadIdx.x) >> 6, lane = threadIdx.x & 63;
    if (row >= M) return;
    const float* xr = row < MP ? xp + (size_t)row * D : xs + (size_t)(row - MP) * D;
    float4 v[4]; float ss = 0.f;
#pragma unroll
    for (int j = 0; j < 4; ++j) { v[j] = ((const float4*)xr)[lane + 64 * j]; ss += v[j].x * v[j].x + v[j].y * v[j].y + v[j].z * v[j].z + v[j].w * v[j].w; }
#pragma unroll
    for (int o = 1; o < 64; o <<= 1) ss += __shfl_xor(ss, o);
    const float rstd = rsqrtf(ss * (1.f / D) + EPS);
#pragma unroll
    for (int j = 0; j < 4; ++j) { const float4 gv = ((const float4*)g)[lane + 64 * j];
        ushort4 o; o.x = f2bf(v[j].x * rstd * gv.x); o.y = f2bf(v[j].y * rstd * gv.y); o.z = f2bf(v[j].z * rstd * gv.z); o.w = f2bf(v[j].w * rstd * gv.w);
        ((ushort4*)(out + (size_t)row * D))[lane + 64 * j] = o; }
}
__global__ void __launch_bounds__(256) k_cvt_pe(const float* __restrict__ pp, const float* __restrict__ ps, bf16_t* __restrict__ out) {
    const size_t i = (size_t)blockIdx.x * 256 + threadIdx.x;
    if (i >= (size_t)M * PE / 4) return;
    const size_t e = i * 4; const float4 v = e < (size_t)MP * PE ? ((const float4*)pp)[i] : ((const float4*)ps)[i - (size_t)MP * PE / 4];
    ushort4 o; o.x = f2bf(v.x); o.y = f2bf(v.y); o.z = f2bf(v.z); o.w = f2bf(v.w); ((ushort4*)out)[i] = o;
}

struct GemmArgs { const bf16_t* A; const float* W; int lda, N, K, pad; };
template <class Epi>
__global__ void __launch_bounds__(256) k_gemm(GemmArgs ga, Epi epi) {
    const bf16_t* __restrict__ A = ga.A; const float* __restrict__ W = ga.W; const int lda = ga.lda, N = ga.N, K = ga.K;
    __shared__ __attribute__((aligned(16))) bf16_t As[64][40];
    __shared__ __attribute__((aligned(16))) bf16_t Bs[64][40];
    const int tid = threadIdx.x, lane = tid & 63, w = tid >> 6, fr = lane & 15, fq = lane >> 4;
    const int n0 = blockIdx.x * 64, m0 = blockIdx.y * 64;
    f32x4 acc[4];
#pragma unroll
    for (int i = 0; i < 4; ++i) acc[i] = (f32x4){0.f, 0.f, 0.f, 0.f};
    const int ar = tid >> 2, ac = (tid & 3) * 8;
    const int wk = tid >> 3, wn = (tid & 7) * 8;
    for (int k0 = 0; k0 < K; k0 += 32) {
        const uint4 av = *(const uint4*)(A + (size_t)(m0 + ar) * lda + k0 + ac);
        const float4 w0 = *(const float4*)(W + (size_t)(k0 + wk) * N + n0 + wn), w1 = *(const float4*)(W + (size_t)(k0 + wk) * N + n0 + wn + 4);
        __syncthreads();
        *(uint4*)&As[ar][ac] = av;
        Bs[wn + 0][wk] = f2bf(w0.x); Bs[wn + 1][wk] = f2bf(w0.y); Bs[wn + 2][wk] = f2bf(w0.z); Bs[wn + 3][wk] = f2bf(w0.w);
        Bs[wn + 4][wk] = f2bf(w1.x); Bs[wn + 5][wk] = f2bf(w1.y); Bs[wn + 6][wk] = f2bf(w1.z); Bs[wn + 7][wk] = f2bf(w1.w);
        __syncthreads();
        const bf16x8 a = *(const bf16x8*)&As[16 * w + fr][8 * fq];
#pragma unroll
        for (int nt = 0; nt < 4; ++nt) { const bf16x8 b = *(const bf16x8*)&Bs[16 * nt + fr][8 * fq]; acc[nt] = __builtin_amdgcn_mfma_f32_16x16x32_bf16(a, b, acc[nt], 0, 0, 0); }
    }
#pragma unroll
    for (int nt = 0; nt < 4; ++nt)
#pragma unroll
        for (int j = 0; j < 4; ++j) epi(m0 + 16 * w + fq * 4 + j, n0 + 16 * nt + fr, acc[nt][j]);
}
struct EpiBf16 { bf16_t* out; int ld; int pad; __device__ void operator()(int r, int c, float v) const { out[(size_t)r * ld + c] = f2bf(v); } };
struct EpiF32 { float* out; int ld; int pad; __device__ void operator()(int r, int c, float v) const { out[(size_t)r * ld + c] = v; } };
struct EpiGate { const bf16_t* gate; float* out; __device__ void operator()(int r, int c, float v) const { const size_t i = (size_t)r * D + c; out[i] = v * bf2f(gate[i]); } };
struct EpiMix { const float* t1; const bf16_t* gate; bf16_t* out; __device__ void operator()(int r, int c, float v) const { const size_t i = (size_t)r * D + c; out[i] = f2bf(t1[i] + v * bf2f(gate[i])); } };
struct EpiRes { const float* rp; const float* rs; float* out; __device__ void operator()(int r, int c, float v) const {
    const float res = r < MP ? rp[(size_t)r * D + c] : rs[(size_t)(r - MP) * D + c]; out[(size_t)r * D + c] = res + v; } };
struct EpiFinal { float* y; const float* tpe; __device__ void operator()(int r, int c, float v) const { const size_t i = (size_t)r * D + c; y[i] = y[i] + tpe[i] * sigmoidf_(v); } };

struct PostIn { const bf16_t* Z; const float *g_q, *g_k; bf16_t *QD, *KD, *VD, *QR, *KR, *VR, *GRS, *GD, *GT; float *kp, *ks, *vp, *vs; };
__global__ void __launch_bounds__(256) k_post_in(PostIn p) {
    const int m = blockIdx.x, tid = threadIdx.x; int b, t, pos; row_info(m, b, t, pos);
    const bf16_t* z = p.Z + (size_t)m * DIN;
    float* kout = m < MP ? p.kp + (size_t)m * 512 : p.ks + (size_t)(m - MP) * 512;
    float* vout = m < MP ? p.vp + (size_t)m * 512 : p.vs + (size_t)(m - MP) * 512;
    {
        const int c = tid * 2; const float q0 = bf2f(z[c]), q1 = bf2f(z[c + 1]), k0 = bf2f(z[512 + c]), k1 = bf2f(z[512 + c + 1]);
        float sq = q0 * q0 + q1 * q1, sk = k0 * k0 + k1 * k1;
#pragma unroll
        for (int o = 1; o < 32; o <<= 1) { sq += __shfl_xor(sq, o); sk += __shfl_xor(sk, o); }
        const float rq = rsqrtf(sq * (1.f / 64.f) + EPS) * 0.125f, rk = rsqrtf(sk * (1.f / 64.f) + EPS);
        const int d = c & 63;
        p.QD[(size_t)m * 512 + c] = f2bf(q0 * rq * p.g_q[d]); p.QD[(size_t)m * 512 + c + 1] = f2bf(q1 * rq * p.g_q[d + 1]);
        const float kn0 = k0 * rk * p.g_k[d], kn1 = k1 * rk * p.g_k[d + 1];
        p.KD[(size_t)m * 512 + c] = f2bf(kn0); p.KD[(size_t)m * 512 + c + 1] = f2bf(kn1); kout[c] = kn0; kout[c + 1] = kn1;
        const float v0 = bf2f(z[1024 + c]), v1 = bf2f(z[1024 + c + 1]);
        p.VD[(size_t)m * 512 + c] = z[1024 + c]; p.VD[(size_t)m * 512 + c + 1] = z[1024 + c + 1]; vout[c] = v0; vout[c + 1] = v1;
    }
    {
        const int h = tid >> 6, i = tid & 63;
        const float inv = powf(10000.f, -(float)i / 64.f); const float ang = (float)pos * inv; float sn, cs; sincosf(ang, &sn, &cs);
        const float q1 = bf2f(z[1536 + h * 128 + i]), q2 = bf2f(z[1536 + h * 128 + 64 + i]);
        p.QR[(size_t)m * 512 + h * 128 + i] = f2bf(q1 * cs - q2 * sn); p.QR[(size_t)m * 512 + h * 128 + 64 + i] = f2bf(q1 * sn + q2 * cs);
        const float k1 = bf2f(z[2048 + h * 128 + i]), k2 = bf2f(z[2048 + h * 128 + 64 + i]); const float sc = 0.08838834764831845f;
        p.KR[(size_t)m * 512 + h * 128 + i] = f2bf((k1 * cs - k2 * sn) * sc); p.KR[(size_t)m * 512 + h * 128 + 64 + i] = f2bf((k1 * sn + k2 * cs) * sc);
    }
    for (int c = tid; c < 512; c += 256) { p.VR[(size_t)m * 512 + c] = z[2560 + c]; const float g = bf2f(z[3072 + c]); p.GRS[(size_t)m * 512 + c] = f2bf(g * sigmoidf_(g)); }
    for (int c = tid; c < 1024; c += 256) { p.GD[(size_t)m * D + c] = f2bf(sigmoidf_(bf2f(z[3584 + c]))); p.GT[(size_t)m * D + c] = f2bf(sigmoidf_(bf2f(z[4608 + c]))); }
}

struct AttnP { const bf16_t *QD, *KD, *VD; const float *ck, *cv, *rel_bias, *lq1, *lk1, *lq2, *lk2, *g_da; bf16_t* OD; int bid0, pad; };
__global__ void __launch_bounds__(256) k_attn(AttnP p) {
    __shared__ __attribute__((aligned(16))) bf16_t Ks[64][136];
    __shared__ __attribute__((aligned(16))) bf16_t Vs[64][136];
    __shared__ __attribute__((aligned(16))) bf16_t Qs[32][136];
    __shared__ float As[32][65];
    __shared__ float btab[192];
    __shared__ float lam_s;
    const int tid = threadIdx.x; int bid = blockIdx.x + p.bid0;
    int sample, b, h, q0pos, qrow0, nk;
    if (bid < 16 * 4 * 64) { sample = 0; const int qb = bid & 63; h = (bid >> 6) & 3; b = bid >> 8; q0pos = qb * 32; qrow0 = b * TP + qb * 32; nk = ((qb >> 1) + 1) * 64; }
    else { bid -= 16 * 4 * 64; sample = 1; h = bid & 3; b = bid >> 2; q0pos = PAST; qrow0 = MP + b * TS; nk = PAST + TS; }
    if (tid < 192) btab[tid] = p.rel_bias[t5_bucket(tid - 127) * 4 + h];
    if (tid == 0) { float a = 0.f, c = 0.f; for (int i = 0; i < 64; ++i) { a += p.lq1[i] * p.lk1[i]; c += p.lq2[i] * p.lk2[i]; } lam_s = __expf(a) - __expf(c) + LAM_INIT; }
    for (int e = tid; e < 32 * 128; e += 256) { const int r = e >> 7, c = e & 127; Qs[r][c] = p.QD[(size_t)(qrow0 + r) * 512 + h * 128 + c]; }
    const int qi = tid >> 3, part = tid & 7; const int qpos = q0pos + qi;
    const int ntile = (nk + 63) / 64;
    float m1 = -1e30f, l1 = 0.f, m2 = -1e30f, l2 = 0.f;
    float o[16];
#pragma unroll
    for (int i = 0; i < 16; ++i) o[i] = 0.f;
    for (int sweep = 0; sweep < 2; ++sweep) {
        for (int tl = 0; tl < ntile; ++tl) {
            __syncthreads();
            for (int e = tid; e < 64 * 128; e += 256) { const int r = e >> 7, c = e & 127; const int j = tl * 64 + r; bf16_t kv = 0, vv = 0;
                if (j < nk) {
                    if (!sample) { const size_t row = (size_t)b * TP + j; kv = p.KD[row * 512 + h * 128 + c]; vv = p.VD[row * 512 + h * 128 + c]; }
                    else if (j < PAST) { const size_t o_ = (((size_t)b * PAST + j) * 4 + h) * 128 + c; kv = f2bf(p.ck[o_]); vv = f2bf(p.cv[o_]); }
                    else { const size_t row = (size_t)MP + b * TS + (j - PAST); kv = p.KD[row * 512 + h * 128 + c]; vv = p.VD[row * 512 + h * 128 + c]; }
                }
                Ks[r][c] = kv; Vs[r][c] = vv; }
            __syncthreads();
            float s1[8], s2[8];
#pragma unroll
            for (int kk = 0; kk < 8; ++kk) { const int r = part * 8 + kk; float a1 = 0.f, a2 = 0.f;
                for (int d = 0; d < 64; ++d) { a1 += bf2f(Qs[qi][d]) * bf2f(Ks[r][d]); a2 += bf2f(Qs[qi][64 + d]) * bf2f(Ks[r][64 + d]); }
                const int j = tl * 64 + r; const int rel = j - qpos; const float bias = rel < -127 ? btab[0] : btab[rel + 127];
                s1[kk] = j < nk ? a1 + bias : -1e30f; s2[kk] = j < nk ? a2 + bias : -1e30f; }
            if (sweep == 0) {
#pragma unroll
                for (int kk = 0; kk < 8; ++kk) {
                    if (s1[kk] > -1e29f) { if (s1[kk] > m1) { l1 = l1 * __expf(m1 - s1[kk]) + 1.f; m1 = s1[kk]; } else l1 += __expf(s1[kk] - m1); }
                    if (s2[kk] > -1e29f) { if (s2[kk] > m2) { l2 = l2 * __expf(m2 - s2[kk]) + 1.f; m2 = s2[kk]; } else l2 += __expf(s2[kk] - m2); } }
            } else {
                const float lam = lam_s;
#pragma unroll
                for (int kk = 0; kk < 8; ++kk) { const float a = s1[kk] > -1e29f ? __expf(s1[kk] - m1) * l1 - lam * __expf(s2[kk] - m2) * l2 : 0.f; As[qi][part * 8 + kk] = a; }
                __syncthreads();
                for (int r = 0; r < 64; ++r) { const float a = As[qi][r];
#pragma unroll
                    for (int i = 0; i < 16; ++i) o[i] += a * bf2f(Vs[r][part * 16 + i]); }
            }
        }
        if (sweep == 0) {
            float M1 = m1, M2 = m2;
#pragma unroll
            for (int of = 1; of < 8; of <<= 1) { M1 = fmaxf(M1, __shfl_xor(M1, of)); M2 = fmaxf(M2, __shfl_xor(M2, of)); }
            float L1 = l1 * __expf(m1 - M1), L2 = l2 * __expf(m2 - M2);
#pragma unroll
            for (int of = 1; of < 8; of <<= 1) { L1 += __shfl_xor(L1, of); L2 += __shfl_xor(L2, of); }
            m1 = M1; m2 = M2; l1 = 1.f / L1; l2 = 1.f / L2;
        }
    }
    float ss = 0.f;
#pragma unroll
    for (int i = 0; i < 16; ++i) ss += o[i] * o[i];
#pragma unroll
    for (int of = 1; of < 8; of <<= 1) ss += __shfl_xor(ss, of);
    const float rstd = rsqrtf(ss * (1.f / 128.f) + EPS) * (1.f - LAM_INIT);
#pragma unroll
    for (int i = 0; i < 16; ++i) p.OD[(size_t)(qrow0 + qi) * 512 + h * 128 + part * 16 + i] = f2bf(o[i] * rstd * p.g_da[part * 16 + i]);
}

struct RetP { const bf16_t *QR, *KR, *VR, *GRS; const float *s0, *g_rt; bf16_t* OR; float *rp, *rs; };
__global__ void __launch_bounds__(256) k_ret(RetP p) {
    __shared__ float qs[128], ks[128], vs[128], part[2][128], red[2];
    const int tid = threadIdx.x, e = tid & 127, dh = tid >> 7; int bid = blockIdx.x;
    int sample, b, h, row0, T;
    if (bid < 64) { sample = 0; h = bid & 3; b = bid >> 2; row0 = b * TP; T = TP; } else { bid -= 64; sample = 1; h = bid & 3; b = bid >> 2; row0 = MP + b * TS; T = TS; }
    const float gamma = 1.f - exp2f(-5.f - (float)h);
    float S[64];
#pragma unroll
    for (int i = 0; i < 64; ++i) S[i] = sample ? p.s0[(((size_t)b * 4 + h) * 128 + dh * 64 + i) * 128 + e] : 0.f;
    for (int n = 0; n < T; ++n) {
        const size_t base = (size_t)(row0 + n) * 512 + h * 128;
        __syncthreads();
        if (tid < 128) { qs[tid] = bf2f(p.QR[base + tid]); ks[tid] = bf2f(p.KR[base + tid]); } else { vs[tid - 128] = bf2f(p.VR[base + tid - 128]); }
        __syncthreads();
        const float ve = vs[e]; float po = 0.f;
#pragma unroll
        for (int i = 0; i < 64; ++i) { S[i] = gamma * S[i] + ks[dh * 64 + i] * ve; po += qs[dh * 64 + i] * S[i]; }
        part[dh][e] = po;
        __syncthreads();
        float ov = 0.f, sq = 0.f;
        if (tid < 128) { ov = part[0][e] + part[1][e]; sq = ov * ov; }
#pragma unroll
        for (int of = 1; of < 64; of <<= 1) sq += __shfl_xor(sq, of);
        if (tid < 128 && (tid & 63) == 0) red[tid >> 6] = sq;
        __syncthreads();
        if (tid < 128) { const float rstd = rsqrtf((red[0] + red[1]) * (1.f / 128.f) + EPS);
            p.OR[base + e] = f2bf(ov * rstd * p.g_rt[e] * bf2f(p.GRS[base + e])); }
    }
    float* so = sample ? p.rs : p.rp;
#pragma unroll
    for (int i = 0; i < 64; ++i) so[(((size_t)b * 4 + h) * 128 + dh * 64 + i) * 128 + e] = S[i];
}

struct ConvP { const bf16_t *G, *U; const float *sc, *cw, *cb; bf16_t* ACT; float *cp, *cs; };
__global__ void __launch_bounds__(256) k_conv(ConvP p) {
    const int m = blockIdx.x; int b, t, pos; row_info(m, b, t, pos); const bool sample = m >= MP; const int T = sample ? TS : TP;
    for (int j = threadIdx.x; j < DFF; j += 256) {
        const float g0 = bf2f(p.G[(size_t)m * DFF + j]);
        const float g1 = t >= 1 ? bf2f(p.G[(size_t)(m - 1) * DFF + j]) : (sample ? p.sc[((size_t)b * 2 + 1) * DFF + j] : 0.f);
        const float g2 = t >= 2 ? bf2f(p.G[(size_t)(m - 2) * DFF + j]) : (sample ? p.sc[((size_t)b * 2 + t) * DFF + j] : 0.f);
        const float gc = p.cb[j] + g2 * p.cw[j] + g1 * p.cw[DFF + j] + g0 * p.cw[2 * DFF + j];
        p.ACT[(size_t)m * DFF + j] = f2bf(gelu_tanh(gc) * bf2f(p.U[(size_t)m * DFF + j]));
        if (t >= T - 2) { float* co = sample ? p.cs : p.cp; co[((size_t)b * 2 + (t - (T - 2))) * DFF + j] = g0; }
    }
}

#include <cstring>
namespace pg8 {
#define PG8_LAS __attribute__((address_space(3)))
typedef unsigned short bf16_t;
typedef short bf16x8 __attribute__((ext_vector_type(8)));
typedef float f32x4 __attribute__((ext_vector_type(4)));
typedef unsigned u32x4 __attribute__((ext_vector_type(4)));
constexpr int BM = 256, BK = 64, HALF = 128, HTB = HALF * BK * 2  , STAGE_BYTES = 8 * HTB, NXCD = 8, WGM = 8;

__host__ __device__ __forceinline__ int lds_byte(int r, int c) { const int st = (r >> 4) * 2 + (c >> 5), rr = r & 15, cc = c & 31, ob = rr * 64 + cc * 2; return st * 1024 + (ob ^ (((ob >> 9) & 1) << 5)); }
__host__ __device__ __forceinline__ void stage_rc(int b, int& R, int& C) { const int st = b / 1024, sb = b % 1024, swz = sb ^ (((sb >> 9) & 1) << 5); R = (st >> 1) * 16 + swz / 64; C = (st & 1) * 32 + (swz % 64) / 2; }
__host__ __device__ __forceinline__ int perm32(int rho) { const int n = rho >> 4, i = rho & 15; return 8 * (i >> 2) + 4 * n + (i & 3); }

struct Unit { int pm, pn; };
struct Gemm { const bf16_t* A; const bf16_t* Bt; int M, N, K; };

struct StaticOrder {
    int nM, nN, nwg, G, c;
    __host__ __device__ void init(int M, int N, int G_, int c_) { nM = M / BM; nN = N / BM; nwg = nM * nN; G = G_; c = c_; }
    __host__ __device__ bool next(int i, Unit& u) const {
        const long L = (long)i * G + c; if (L >= nwg) return false;
        int wgid = (int)L; { const int q = nwg / NXCD, r = nwg % NXCD, xcd = wgid % NXCD, off = wgid / NXCD; wgid = (xcd < r ? xcd * (q + 1) : r * (q + 1) + (xcd - r) * q) + off; }
        const int nig = WGM * nN, gid = wgid / nig, fm = gid * WGM, gsz = (nM - fm) < WGM ? (nM - fm) : WGM;
        u.pm = fm + ((wgid % nig) % gsz); u.pn = (wgid % nig) / gsz; return true;
    }
    __device__ __forceinline__ void a_ready(const Unit&) const {}
    __device__ __forceinline__ void done(const Unit&) const {}
};

__device__ __forceinline__ unsigned cvt_pk_bf16(float lo, float hi) { unsigned r; asm volatile("v_cvt_pk_bf16_f32 %0, %1, %2" : "=v"(r) : "v"(lo), "v"(hi)); return r; }
typedef float f32x2 __attribute__((ext_vector_type(2)));
__device__ __forceinline__ f32x2 gelu_pk(f32x2 v) {
    const f32x2 av = __builtin_elementwise_abs(v), d = av * 0.2316418882f + 1.0f;
    f32x2 t; t.x = __builtin_amdgcn_rcpf(d.x); t.y = __builtin_amdgcn_rcpf(d.y);
    f32x2 q = t * 0.5307027145f + (-0.7265760135f); q = q * t + 0.7107068705f; q = q * t + (-0.142248368f); q = q * t + 0.127414796f; q = q * t;
    const f32x2 s = (v * v) * (-0.72134752044f);
    f32x2 e; e.x = __builtin_amdgcn_exp2f(s.x); e.y = __builtin_amdgcn_exp2f(s.y);
    const f32x2 m = v * (q * e), r = v - m;
    f32x2 o; o.x = v.x < 0.f ? m.x : r.x; o.y = v.y < 0.f ? m.y : r.y; return o;
}


typedef __bf16 bf16x2_t __attribute__((ext_vector_type(2)));
__device__ __forceinline__ unsigned cvtpk(float lo, float hi) { f32x2 v = {lo, hi}; bf16x2_t b = __builtin_convertvector(v, bf16x2_t); return __builtin_bit_cast(unsigned, b); }
__device__ __forceinline__ u32x4 pack8(f32x4 a, f32x4 b) { u32x4 w; w.x = cvtpk(a[0], a[1]); w.y = cvtpk(a[2], a[3]); w.z = cvtpk(b[0], b[1]); w.w = cvtpk(b[2], b[3]); return w; }
__device__ __forceinline__ float fsig(float x) { return __builtin_amdgcn_rcpf(1.f + __builtin_amdgcn_exp2f(-1.4426950408889634f * x)); }
__device__ __forceinline__ f32x4 fsig4(f32x4 x) { return (f32x4){fsig(x[0]), fsig(x[1]), fsig(x[2]), fsig(x[3])}; }

constexpr int E_MP = 32768;
struct EpiIn {
    static constexpr bool PERM = true, AFTER_DRAIN = false; static constexpr int MID_T = 0;
    bf16_t *QD, *KD, *VD, *QR, *KR, *VR, *GRS, *GD, *GT; float *kp, *ks, *vp, *vs; const float *g_q, *g_k; const float* rot;
    __device__ __forceinline__ void operator()(const f32x4 (&acc)[2][2][4][2], const Unit& u, int wr, int wc, int fr, int fq) const {
        const int pn = u.pn; const int rbase = u.pm * BM + wr * 64 + fr; const bool samp = u.pm >= E_MP / BM;
        if (pn < 4) {
            const bool isq = pn < 2; const float* gg = isq ? g_q : g_k; const float sc = isq ? 0.125f : 1.f;
            f32x4 gv[2][2];
#pragma unroll
            for (int bj = 0; bj < 2; ++bj)
#pragma unroll
                for (int n = 0; n < 2; ++n) gv[bj][n] = *(const f32x4*)(gg + 32 * bj + 8 * fq + 4 * n);
            const int col = (pn & 1) * 256 + 64 * wc + 8 * fq;
            bf16_t* dst = isq ? QD : KD; float* ko = samp ? ks - (size_t)E_MP * 512 : kp;
#pragma unroll
            for (int ai = 0; ai < 2; ++ai)
#pragma unroll
                for (int m = 0; m < 4; ++m) { const size_t row = (size_t)(rbase + ai * HALF + m * 16);
                    float ss = 0.f;
#pragma unroll
                    for (int bj = 0; bj < 2; ++bj)
#pragma unroll
                        for (int n = 0; n < 2; ++n) { const f32x4 x = acc[ai][bj][m][n]; ss += (x[0] * x[0] + x[1] * x[1]) + (x[2] * x[2] + x[3] * x[3]); }
                    ss += __shfl_xor(ss, 16); ss += __shfl_xor(ss, 32);
                    const float rs = __builtin_amdgcn_rsqf(ss * (1.f / 64.f) + 1e-6f) * sc;
#pragma unroll
                    for (int bj = 0; bj < 2; ++bj) { const f32x4 v0 = acc[ai][bj][m][0] * rs * gv[bj][0], v1 = acc[ai][bj][m][1] * rs * gv[bj][1];
                        *(u32x4*)(dst + row * 512 + col + 32 * bj) = pack8(v0, v1);
                        if (!isq) { float* kr_ = ko + row * 512 + col + 32 * bj; *(f32x4*)kr_ = v0; *(f32x4*)(kr_ + 4) = v1; } } }
        } else if (pn < 6) {
            const int col = (pn - 4) * 256 + 32 * wc + 8 * fq; float* vo = samp ? vs - (size_t)E_MP * 512 : vp;
#pragma unroll
            for (int ai = 0; ai < 2; ++ai)
#pragma unroll
                for (int m = 0; m < 4; ++m) { const size_t row = (size_t)(rbase + ai * HALF + m * 16);
#pragma unroll
                    for (int bj = 0; bj < 2; ++bj) { const f32x4 v0 = acc[ai][bj][m][0], v1 = acc[ai][bj][m][1];
                        *(u32x4*)(VD + row * 512 + col + 128 * bj) = pack8(v0, v1);
                        float* vr_ = vo + row * 512 + col + 128 * bj; *(f32x4*)vr_ = v0; *(f32x4*)(vr_ + 4) = v1; } }
        } else if (pn < 10) {
            const bool isq = pn < 8; const int head = (pn & 1) * 2 + (wc >> 1); const int i0 = 32 * (wc & 1) + 8 * fq; const float sc = isq ? 1.f : 0.08838834764831845f;
            bf16_t* dst = isq ? QR : KR;
#pragma unroll
            for (int ai = 0; ai < 2; ++ai)
#pragma unroll
                for (int m = 0; m < 4; ++m) { const int rowi = rbase + ai * HALF + m * 16; const size_t row = (size_t)rowi;
                    const int pidx = samp ? 2048 + ((rowi - E_MP) & 31) : (rowi & 2047);
                    const f32x4* rt = (const f32x4*)(rot + ((size_t)pidx * 64 + i0) * 2);
                    f32x4 o1[2], o2[2];
#pragma unroll
                    for (int n = 0; n < 2; ++n) { const f32x4 ra = rt[2 * n], rb = rt[2 * n + 1]; const f32x4 x1 = acc[ai][0][m][n], x2 = acc[ai][1][m][n];
                        const f32x4 cs = (f32x4){ra[0], ra[2], rb[0], rb[2]}, sn = (f32x4){ra[1], ra[3], rb[1], rb[3]};
                        o1[n] = (x1 * cs - x2 * sn) * sc; o2[n] = (x1 * sn + x2 * cs) * sc; }
                    *(u32x4*)(dst + row * 512 + head * 128 + i0) = pack8(o1[0], o1[1]);
                    *(u32x4*)(dst + row * 512 + head * 128 + 64 + i0) = pack8(o2[0], o2[1]); }
        } else if (pn < 14) {
            const bool isv = pn < 12; const int col = (pn & 1) * 256 + 32 * wc + 8 * fq; bf16_t* dst = isv ? VR : GRS;
#pragma unroll
            for (int ai = 0; ai < 2; ++ai)
#pragma unroll
                for (int m = 0; m < 4; ++m) { const size_t row = (size_t)(rbase + ai * HALF + m * 16);
#pragma unroll
                    for (int bj = 0; bj < 2; ++bj) { f32x4 v0 = acc[ai][bj][m][0], v1 = acc[ai][bj][m][1];
                        if (!isv) { v0 = v0 * fsig4(v0); v1 = v1 * fsig4(v1); }
                        *(u32x4*)(dst + row * 512 + col + 128 * bj) = pack8(v0, v1); } }
        } else {
            const bool isd = pn < 18; const int col = ((pn - 14) & 3) * 256 + 32 * wc + 8 * fq; bf16_t* dst = isd ? GD : GT;
#pragma unroll
            for (int ai = 0; ai < 2; ++ai)
#pragma unroll
                for (int m = 0; m < 4; ++m) { const size_t row = (size_t)(rbase + ai * HALF + m * 16);
#pragma unroll
                    for (int bj = 0; bj < 2; ++bj) { const f32x4 v0 = fsig4(acc[ai][bj][m][0]), v1 = fsig4(acc[ai][bj][m][1]);
                        *(u32x4*)(dst + row * 1024 + col + 128 * bj) = pack8(v0, v1); } }
        }
    }
};
struct EpiResid {
    static constexpr bool PERM = true, AFTER_DRAIN = false; static constexpr int MID_T = 0;
    const float* rp; const float* rs; float* out;
    __device__ __forceinline__ void operator()(const f32x4 (&acc)[2][2][4][2], const Unit& u, int wr, int wc, int fr, int fq) const {
        const int rbase = u.pm * BM + wr * 64 + fr; const bool samp = u.pm >= E_MP / BM; const int col = u.pn * 256 + 32 * wc + 8 * fq;
        const float* res = samp ? rs - (size_t)E_MP * 1024 : rp;
#pragma unroll
        for (int ai = 0; ai < 2; ++ai)
#pragma unroll
            for (int m = 0; m < 4; ++m) { const size_t row = (size_t)(rbase + ai * HALF + m * 16);
#pragma unroll
                for (int bj = 0; bj < 2; ++bj) { const size_t o = row * 1024 + col + 128 * bj;
                    const f32x4 r0 = *(const f32x4*)(res + o), r1 = *(const f32x4*)(res + o + 4);
                    *(f32x4*)(out + o) = r0 + acc[ai][bj][m][0]; *(f32x4*)(out + o + 4) = r1 + acc[ai][bj][m][1]; } }
    }
};

__device__ __forceinline__ void unpack8(u32x4 w, f32x4& a, f32x4& b) {
    a = (f32x4){__uint_as_float(w.x << 16), __uint_as_float(w.x & 0xffff0000u), __uint_as_float(w.y << 16), __uint_as_float(w.y & 0xffff0000u)};
    b = (f32x4){__uint_as_float(w.z << 16), __uint_as_float(w.z & 0xffff0000u), __uint_as_float(w.w << 16), __uint_as_float(w.w & 0xffff0000u)};
}
struct EpiMixMerged {
    static constexpr bool PERM = true, AFTER_DRAIN = false; static constexpr int MID_T = 8;
    const bf16_t* gd; const bf16_t* gt; bf16_t* mix;
    __device__ __forceinline__ void mid(f32x4 (&acc)[2][2][4][2], const Unit& u, int wr, int wc, int fr, int fq) const {
        int lz = 0; asm volatile("" : "+v"(lz));
        const int rbase = u.pm * BM + wr * 64 + fr + lz; const int col = u.pn * 256 + 32 * wc + 8 * fq;
#pragma unroll
        for (int ai = 0; ai < 2; ++ai)
#pragma unroll
            for (int m = 0; m < 4; ++m) { const size_t row = (size_t)(rbase + ai * HALF + m * 16);
#pragma unroll
                for (int bj = 0; bj < 2; ++bj) { const size_t o = row * 1024 + col + 128 * bj; f32x4 d0, d1, t0, t1; unpack8(*(const u32x4*)(gd + o), d0, d1); unpack8(*(const u32x4*)(gt + o), t0, t1);
#pragma unroll
                    for (int i = 0; i < 4; ++i) { acc[ai][bj][m][0][i] *= d0[i] * __builtin_amdgcn_rcpf(fmaxf(t0[i], 1e-30f)); acc[ai][bj][m][1][i] *= d1[i] * __builtin_amdgcn_rcpf(fmaxf(t1[i], 1e-30f)); } }
                asm volatile("" ::: "memory"); }
    }
    __device__ __forceinline__ void operator()(const f32x4 (&acc)[2][2][4][2], const Unit& u, int wr, int wc, int fr, int fq) const {
        const int rbase = u.pm * BM + wr * 64 + fr; const int col = u.pn * 256 + 32 * wc + 8 * fq;
#pragma unroll
        for (int ai = 0; ai < 2; ++ai)
#pragma unroll
            for (int m = 0; m < 4; ++m) { const size_t row = (size_t)(rbase + ai * HALF + m * 16);
#pragma unroll
                for (int bj = 0; bj < 2; ++bj) { const size_t o = row * 1024 + col + 128 * bj; f32x4 t0, t1; unpack8(*(const u32x4*)(gt + o), t0, t1);
                    *(u32x4*)(mix + o) = pack8(acc[ai][bj][m][0] * t0, acc[ai][bj][m][1] * t1); } }
    }
};
struct EpiResNorm {
    static constexpr bool PERM = true, AFTER_DRAIN = false; static constexpr int MID_T = 0;
    const float* rp; const float* rs; bf16_t* hb; float* ss;
    __device__ __forceinline__ void operator()(const f32x4 (&acc)[2][2][4][2], const Unit& u, int wr, int wc, int fr, int fq) const {
        const int rbase = u.pm * BM + wr * 64 + fr; const bool samp = u.pm >= E_MP / BM; const int col = u.pn * 256 + 32 * wc + 8 * fq;
        const float* res = samp ? rs - (size_t)E_MP * 1024 : rp;
#pragma unroll
        for (int ai = 0; ai < 2; ++ai)
#pragma unroll
            for (int m = 0; m < 4; ++m) { const size_t row = (size_t)(rbase + ai * HALF + m * 16); float sq = 0.f;
#pragma unroll
                for (int bj = 0; bj < 2; ++bj) { const size_t o = row * 1024 + col + 128 * bj;
                    const f32x4 h0 = *(const f32x4*)(res + o) + acc[ai][bj][m][0], h1 = *(const f32x4*)(res + o + 4) + acc[ai][bj][m][1];
                    *(u32x4*)(hb + o) = pack8(h0, h1);
                    sq += (h0[0] * h0[0] + h0[1] * h0[1]) + (h0[2] * h0[2] + h0[3] * h0[3]) + (h1[0] * h1[0] + h1[1] * h1[1]) + (h1[2] * h1[2] + h1[3] * h1[3]); }
                sq += __shfl_xor(sq, 16); sq += __shfl_xor(sq, 32);
                if (fq == 0) ss[row * 16 + u.pn * 4 + wc] = sq;
                asm volatile("" ::: "memory"); }
    }
};
struct EpiResNormB {
    static constexpr bool PERM = true, AFTER_DRAIN = false; static constexpr int MID_T = 0;
    bf16_t* hb; float* ss;
    __device__ __forceinline__ void operator()(const f32x4 (&acc)[2][2][4][2], const Unit& u, int wr, int wc, int fr, int fq) const {
        const int rbase = u.pm * BM + wr * 64 + fr; const int col = u.pn * 256 + 32 * wc + 8 * fq;
#pragma unroll
        for (int ai = 0; ai < 2; ++ai)
#pragma unroll
            for (int m = 0; m < 4; ++m) { const size_t row = (size_t)(rbase + ai * HALF + m * 16); float sq = 0.f;
#pragma unroll
                for (int bj = 0; bj < 2; ++bj) { const size_t o = row * 1024 + col + 128 * bj; f32x4 r0, r1; unpack8(*(const u32x4*)(hb + o), r0, r1);
                    const f32x4 h0 = r0 + acc[ai][bj][m][0], h1 = r1 + acc[ai][bj][m][1];
                    *(u32x4*)(hb + o) = pack8(h0, h1);
                    sq += (h0[0] * h0[0] + h0[1] * h0[1]) + (h0[2] * h0[2] + h0[3] * h0[3]) + (h1[0] * h1[0] + h1[1] * h1[1]) + (h1[2] * h1[2] + h1[3] * h1[3]); }
                sq += __shfl_xor(sq, 16); sq += __shfl_xor(sq, 32);
                if (fq == 0) ss[row * 16 + u.pn * 4 + wc] = sq;
                asm volatile("" ::: "memory"); }
    }
};
__device__ __forceinline__ void rstd_table(PG8_LAS float* tab, const float* ss, int pm) {
    const int tid = threadIdx.x;
    if (tid < 256) { const f32x4* p = (const f32x4*)(ss + (size_t)(pm * BM + tid) * 16); const f32x4 a = p[0], b = p[1], c = p[2], d = p[3];
        const float s = ((a[0] + a[1]) + (a[2] + a[3])) + ((b[0] + b[1]) + (b[2] + b[3])) + ((c[0] + c[1]) + (c[2] + c[3])) + ((d[0] + d[1]) + (d[2] + d[3]));
        tab[tid] = __builtin_amdgcn_rsqf(s * (1.f / 1024.f) + 1e-6f); }
    asm volatile("s_waitcnt lgkmcnt(0)" ::: "memory"); __builtin_amdgcn_s_barrier(); asm volatile("" ::: "memory");
}
__device__ __forceinline__ float gelu_t(float x) {
    const float w = x * (-2.3022082f - 0.10294324f * (x * x)); return x * __builtin_amdgcn_rcpf(1.f + __builtin_amdgcn_exp2f(w));
}
constexpr int E_DFF = 2816;
struct EpiGU {
    static constexpr bool PERM = true, AFTER_DRAIN = false; static constexpr int MID_T = 0;
    const float* ss; const float* sc; const float* cw; const float* cb; bf16_t* act; float* headp; float* headu; float* tail; float* cp; float* cs; PG8_LAS float* tab;
    __device__ __forceinline__ void operator()(const f32x4 (&acc)[2][2][4][2], const Unit& u, int wr, int wc, int fr, int fq) const {
        rstd_table(tab, ss, u.pm);
        const int lane = threadIdx.x & 63; const bool samp = u.pm >= E_MP / BM;
        const int src1 = (lane & 48) | ((fr + 15) & 15), src2 = (lane & 48) | ((fr + 14) & 15);
#pragma unroll
        for (int n = 0; n < 2; ++n) {
            const int j0 = u.pn * 128 + 32 * wc + 8 * fq + 4 * n;
            const f32x4 w0 = *(const f32x4*)(cw + j0), w1 = *(const f32x4*)(cw + E_DFF + j0), w2 = *(const f32x4*)(cw + 2 * E_DFF + j0), bb = *(const f32x4*)(cb + j0);
#pragma unroll
            for (int ai = 0; ai < 2; ++ai) {
                const int r0t = ai * HALF + wr * 64;
                const int grow0 = u.pm * BM + r0t;
                f32x4 xm1 = (f32x4){0.f, 0.f, 0.f, 0.f};
#pragma unroll
                for (int m = 0; m < 4; ++m) {
                    const int rowi = grow0 + m * 16 + fr; const float rs = tab[r0t + m * 16 + fr];
                    const f32x4 g = acc[ai][0][m][n] * rs, uu = acc[ai][1][m][n] * rs;
                    if (samp && (m & 1) == 0) { const int b = (rowi - fr - E_MP) >> 5; const int sr = fr >= 14 ? fr - 14 : 0; xm1 = *(const f32x4*)(sc + ((size_t)b * 2 + sr) * E_DFF + j0); }
                    f32x4 gc;
#pragma unroll
                    for (int i = 0; i < 4; ++i) { const float y1 = fr == 15 ? xm1[i] : g[i], y2 = fr >= 14 ? xm1[i] : g[i];
                        const float p1 = __shfl(y1, src1), p2 = __shfl(y2, src2);
                        gc[i] = bb[i] + w0[i] * p2 + w1[i] * p1 + w2[i] * g[i]; }
                    const bool head = !samp && m == 0 && fr < 2;
                    if (head) { const size_t o = ((size_t)(grow0 >> 6) * 2 + fr) * E_DFF + j0; *(f32x4*)(headp + o) = gc; *(f32x4*)(headu + o) = uu; }
                    else { uint2 w; w.x = cvtpk(gelu_t(gc[0]) * uu[0], gelu_t(gc[1]) * uu[1]); w.y = cvtpk(gelu_t(gc[2]) * uu[2], gelu_t(gc[3]) * uu[3]);
                        *(uint2*)(act + (size_t)rowi * E_DFF + j0) = w; }
                    if (fr >= 14) {
                        if (samp) { if (m & 1) { const int b = (rowi - E_MP) >> 5; *(f32x4*)(cs + ((size_t)b * 2 + (fr - 14)) * E_DFF + j0) = g; } }
                        else if (m == 3) { *(f32x4*)(tail + ((size_t)(grow0 >> 6) * 2 + (fr - 14)) * E_DFF + j0) = g;
                            if (((grow0 + 64) & 2047) == 0) *(f32x4*)(cp + ((size_t)(grow0 >> 11) * 2 + (fr - 14)) * E_DFF + j0) = g; } }
                    xm1 = g;
                }
            }
        }
    }
};
struct EpiStoreB16 {
    static constexpr bool PERM = true, AFTER_DRAIN = false; static constexpr int MID_T = 0;
    bf16_t* out;
    __device__ __forceinline__ void operator()(const f32x4 (&acc)[2][2][4][2], const Unit& u, int wr, int wc, int fr, int fq) const {
        const int rbase = u.pm * BM + wr * 64 + fr; const int col = u.pn * 256 + 32 * wc + 8 * fq;
#pragma unroll
        for (int ai = 0; ai < 2; ++ai)
#pragma unroll
            for (int m = 0; m < 4; ++m) { const size_t row = (size_t)(rbase + ai * HALF + m * 16);
#pragma unroll
                for (int bj = 0; bj < 2; ++bj) { const size_t o = row * 1024 + col + 128 * bj; *(u32x4*)(out + o) = pack8(acc[ai][bj][m][0], acc[ai][bj][m][1]); } }
    }
};
struct EpiFinalY {
    static constexpr bool PERM = true, AFTER_DRAIN = false; static constexpr int MID_T = 0;
    const float* ss; const bf16_t* tpe; const bf16_t* h2; float* y; PG8_LAS float* tab;
    __device__ __forceinline__ void operator()(const f32x4 (&acc)[2][2][4][2], const Unit& u, int wr, int wc, int fr, int fq) const {
        rstd_table(tab, ss, u.pm);
        const int rbase = u.pm * BM + wr * 64 + fr; const int col = u.pn * 256 + 32 * wc + 8 * fq;
#pragma unroll
        for (int ai = 0; ai < 2; ++ai)
#pragma unroll
            for (int m = 0; m < 4; ++m) { const size_t row = (size_t)(rbase + ai * HALF + m * 16); const float rs = tab[ai * HALF + wr * 64 + m * 16 + fr];
#pragma unroll
                for (int bj = 0; bj < 2; ++bj) { const size_t o = row * 1024 + col + 128 * bj; f32x4 t0, t1, r0, r1; unpack8(*(const u32x4*)(tpe + o), t0, t1); unpack8(*(const u32x4*)(h2 + o), r0, r1);
                    const f32x4 s0 = fsig4(acc[ai][bj][m][0] * rs), s1 = fsig4(acc[ai][bj][m][1] * rs);
                    *(f32x4*)(y + o) = r0 + t0 * s0; *(f32x4*)(y + o + 4) = r1 + t1 * s1; }
                asm volatile("" ::: "memory"); }
    }
};
template <class Epi, class Sched, bool ALIGN_EPI = false, bool SP2 = false>
__device__ __forceinline__ void gemm_phase(PG8_LAS unsigned char* lds, const Gemm g, const Sched& S, const Epi& E) {
    const int tid = threadIdx.x, wid = __builtin_amdgcn_readfirstlane(tid >> 6), lane = tid & 63, wr = wid >> 2, wc = wid & 3, fr = lane & 15, fq = lane >> 4;
    const int K = g.K, nt = K / BK;
    unsigned voffA[2], voffB[2];
#pragma unroll
    for (int i = 0; i < 2; ++i) { int R, C; stage_rc(tid * 16 + i * 8192, R, C); const int Rb = Epi::PERM ? ((R & ~31) + perm32(R & 31)) : R;
        voffA[i] = (unsigned)(R * K + C) * 2u; voffB[i] = (unsigned)(Rb * K + C) * 2u; }
    const size_t kstep = (size_t)(BK * 2);
    const size_t hstep = (size_t)HALF * K * 2;
    const size_t tstep = 2 * hstep;
    const unsigned ldsw = (unsigned)wid * 1024u;
    const int aoff = lds_byte(wr * 64 + fr, fq * 8), boff = lds_byte(wc * 32 + fr, fq * 8);
#define PG8_SA(b, h) (((b) * 2 + (h)) * HTB)
#define PG8_SB(b, h) ((4 + (b) * 2 + (h)) * HTB)
#define PG8_STAGE(bufoff, gbase, voff) do { _Pragma("unroll") for (int _i = 0; _i < 2; ++_i) \
        __builtin_amdgcn_global_load_lds((const unsigned*)((const char*)(gbase) + (voff)[_i]), (PG8_LAS unsigned*)(lds + (bufoff) + ldsw + _i * 8192), 16, 0, 0); } while (0)
#define PG8_LDA(dst, b, h) do { _Pragma("unroll") for (int m = 0; m < 4; ++m) _Pragma("unroll") for (int k = 0; k < 2; ++k) dst[m][k] = *(const PG8_LAS bf16x8*)(lds + PG8_SA(b, h) + aoff + m * 2048 + k * 1024); } while (0)
#define PG8_LDB(dst, b, h) do { _Pragma("unroll") for (int n = 0; n < 2; ++n) _Pragma("unroll") for (int k = 0; k < 2; ++k) dst[n][k] = *(const PG8_LAS bf16x8*)(lds + PG8_SB(b, h) + boff + n * 2048 + k * 1024); } while (0)
#define PG8_MMA(ai, bj, At, Bt) do { __builtin_amdgcn_s_setprio(1); _Pragma("unroll") for (int m = 0; m < 4; ++m) _Pragma("unroll") for (int n = 0; n < 2; ++n) _Pragma("unroll") for (int k = 0; k < 2; ++k) \
        acc[ai][bj][m][n] = __builtin_amdgcn_mfma_f32_16x16x32_bf16(Bt[n][k], At[m][k], acc[ai][bj][m][n], 0, 0, 0); __builtin_amdgcn_s_setprio(0); } while (0)
#define PG8_WAIT_V(n) asm volatile("s_waitcnt vmcnt(" #n ")" ::: "memory")
#define PG8_WAIT_L(n) asm volatile("s_waitcnt lgkmcnt(" #n ")" ::: "memory")
#define PG8_BAR __builtin_amdgcn_s_barrier()
#define PG8_SCHED __builtin_amdgcn_sched_barrier(0)
    Unit cur, nxt; int ui = 0;
    if (!S.next(0, cur)) return;
    f32x4 acc[2][2][4][2];
#pragma unroll
    for (int a = 0; a < 2; ++a)
#pragma unroll
        for (int b = 0; b < 2; ++b)
#pragma unroll
            for (int m = 0; m < 4; ++m)
#pragma unroll
                for (int n = 0; n < 2; ++n) acc[a][b][m][n] = (f32x4){0.f, 0.f, 0.f, 0.f};
    bf16x8 At[4][2], B0[2][2], B1[2][2];
    const char* cA = (const char*)g.A + (size_t)cur.pm * tstep; const char* cB = (const char*)g.Bt + (size_t)cur.pn * tstep;
    S.a_ready(cur);
    if constexpr (SP2) {
        PG8_STAGE(PG8_SB(0, 0), cB, voffB); PG8_STAGE(PG8_SB(0, 1), cB + hstep, voffB); PG8_STAGE(PG8_SA(0, 0), cA, voffA); PG8_STAGE(PG8_SA(0, 1), cA + hstep, voffA);
        if (wr == 1) PG8_BAR;
        PG8_WAIT_V(2); PG8_BAR;
        PG8_STAGE(PG8_SB(1, 0), cB + kstep, voffB); PG8_STAGE(PG8_SA(1, 0), cA + kstep, voffA); PG8_STAGE(PG8_SB(1, 1), cB + hstep + kstep, voffB);
        PG8_WAIT_V(6); PG8_BAR;
    } else {
        PG8_STAGE(PG8_SB(0, 0), cB, voffB); PG8_STAGE(PG8_SA(0, 0), cA, voffA); PG8_STAGE(PG8_SB(0, 1), cB + hstep, voffB); PG8_STAGE(PG8_SA(0, 1), cA + hstep, voffA);
        if (wr == 1) PG8_BAR;
        PG8_WAIT_V(4); PG8_BAR;
        PG8_STAGE(PG8_SB(1, 0), cB + kstep, voffB); PG8_STAGE(PG8_SA(1, 0), cA + kstep, voffA); PG8_STAGE(PG8_SB(1, 1), cB + hstep + kstep, voffB);
        PG8_WAIT_V(6); PG8_BAR;
    }
    for (;;) {
        const bool has_next = S.next(ui + 1, nxt);
        const char* nA = has_next ? (const char*)g.A + (size_t)nxt.pm * tstep : cA; const char* nB = has_next ? (const char*)g.Bt + (size_t)nxt.pn * tstep : cB;
        for (int t = 0; t < nt; t += 2) {
            if constexpr (Epi::MID_T > 0) { if (t == Epi::MID_T) E.mid(acc, cur, wr, wc, fr, fq); }
            const bool last = (t == nt - 2);
            const char* a1 = cA + (size_t)(t + 1) * kstep;
            const char* a2 = last ? nA : cA + (size_t)(t + 2) * kstep; const char* b2 = last ? nB : cB + (size_t)(t + 2) * kstep;
            const char* a3 = a2 + kstep; const char* b3 = b2 + kstep;
            if (last && has_next) S.a_ready(nxt);
            if constexpr (SP2) {
            PG8_LDB(B0, 0, 0); PG8_LDB(B1, 0, 1); PG8_SCHED; PG8_LDA(At, 0, 0); PG8_STAGE(PG8_SA(1, 1), a1 + hstep, voffA);
            PG8_WAIT_V(8); PG8_WAIT_L(0); PG8_BAR; PG8_MMA(0, 0, At, B0); PG8_MMA(0, 1, At, B1); PG8_BAR; PG8_SCHED;
            PG8_LDA(At, 0, 1); PG8_STAGE(PG8_SB(0, 0), b2, voffB); PG8_STAGE(PG8_SB(0, 1), b2 + hstep, voffB); PG8_STAGE(PG8_SA(0, 0), a2, voffA);
            PG8_WAIT_V(8); PG8_WAIT_L(0); PG8_BAR; PG8_MMA(1, 0, At, B0); PG8_MMA(1, 1, At, B1); PG8_BAR; PG8_SCHED;
            PG8_LDB(B0, 1, 0); PG8_LDB(B1, 1, 1); PG8_SCHED; PG8_LDA(At, 1, 0); PG8_STAGE(PG8_SA(0, 1), a2 + hstep, voffA);
            PG8_WAIT_V(8); PG8_WAIT_L(0); PG8_BAR; PG8_MMA(0, 0, At, B0); PG8_MMA(0, 1, At, B1); PG8_BAR; PG8_SCHED;
            PG8_LDA(At, 1, 1); PG8_STAGE(PG8_SB(1, 0), b3, voffB); PG8_STAGE(PG8_SB(1, 1), b3 + hstep, voffB); PG8_STAGE(PG8_SA(1, 0), a3, voffA);
            PG8_WAIT_V(8); PG8_WAIT_L(0); PG8_BAR; PG8_MMA(1, 0, At, B0); PG8_MMA(1, 1, At, B1); PG8_BAR; PG8_SCHED;
            } else {
            PG8_LDB(B0, 0, 0); PG8_SCHED; PG8_LDA(At, 0, 0); PG8_STAGE(PG8_SA(1, 1), a1 + hstep, voffA);
            PG8_WAIT_L(8); PG8_BAR; PG8_WAIT_L(0); PG8_MMA(0, 0, At, B0); PG8_BAR; PG8_SCHED;
            PG8_LDB(B1, 0, 1); PG8_STAGE(PG8_SB(0, 0), b2, voffB);
            PG8_BAR; PG8_WAIT_L(0); PG8_MMA(0, 1, At, B1); PG8_BAR;
            PG8_LDA(At, 0, 1); PG8_STAGE(PG8_SA(0, 0), a2, voffA);
            PG8_BAR; PG8_WAIT_L(0); PG8_MMA(1, 0, At, B0); PG8_BAR; PG8_SCHED;
            PG8_STAGE(PG8_SB(0, 1), b2 + hstep, voffB);
            PG8_WAIT_V(6); PG8_BAR; PG8_MMA(1, 1, At, B1); PG8_BAR;
            PG8_LDB(B0, 1, 0); PG8_SCHED; PG8_LDA(At, 1, 0); PG8_STAGE(PG8_SA(0, 1), a2 + hstep, voffA);
            PG8_WAIT_L(8); PG8_BAR; PG8_WAIT_L(0); PG8_MMA(0, 0, At, B0); PG8_BAR; PG8_SCHED;
            PG8_LDB(B1, 1, 1); PG8_STAGE(PG8_SB(1, 0), b3, voffB);
            PG8_BAR; PG8_WAIT_L(0); PG8_MMA(0, 1, At, B1); PG8_BAR;
            PG8_LDA(At, 1, 1); PG8_STAGE(PG8_SA(1, 0), a3, voffA);
            PG8_BAR; PG8_WAIT_L(0); PG8_MMA(1, 0, At, B0); PG8_BAR; PG8_SCHED;
            PG8_STAGE(PG8_SB(1, 1), b3 + hstep, voffB);
            PG8_WAIT_V(6); PG8_BAR; PG8_MMA(1, 1, At, B1); PG8_BAR;
            }
        }
        if constexpr (ALIGN_EPI) { if (wr == 0) PG8_BAR; }
        if constexpr (!Epi::AFTER_DRAIN) { E(acc, cur, wr, wc, fr, fq); S.done(cur); }
        if (!has_next) break;
#pragma unroll
        for (int a = 0; a < 2; ++a)
#pragma unroll
            for (int b = 0; b < 2; ++b)
#pragma unroll
                for (int m = 0; m < 4; ++m)
#pragma unroll
                    for (int n = 0; n < 2; ++n) acc[a][b][m][n] = (f32x4){0.f, 0.f, 0.f, 0.f};
        cur = nxt; cA = nA; cB = nB; ++ui;
        if constexpr (ALIGN_EPI) { if (wr == 1) PG8_BAR; }
    }
    PG8_WAIT_V(0);
    if constexpr (!ALIGN_EPI) { if (wr == 0) PG8_BAR; }
    PG8_BAR;
    if constexpr (Epi::AFTER_DRAIN) { E.fused(acc, cur, wr, wc, fr, fq, lds, wid, lane); S.done(cur); }
#undef PG8_SA
#undef PG8_SB
#undef PG8_STAGE
#undef PG8_LDA
#undef PG8_LDB
#undef PG8_MMA
#undef PG8_WAIT_V
#undef PG8_WAIT_L
#undef PG8_BAR
#undef PG8_SCHED
}
}

namespace att {
typedef short bf16x8 __attribute__((ext_vector_type(8)));
typedef short s16x4 __attribute__((ext_vector_type(4)));
typedef float f32x16 __attribute__((ext_vector_type(16)));
typedef float f32x4 __attribute__((ext_vector_type(4)));
typedef float f32x2 __attribute__((ext_vector_type(2)));
typedef __bf16 bf16x2_t __attribute__((ext_vector_type(2)));
typedef __attribute__((address_space(3))) unsigned char* lptr;
typedef unsigned u32x4 __attribute__((ext_vector_type(4)));
constexpr int LK = 0, LV = 32768, LQ = 65536;
constexpr float LOG2E = 1.4426950408889634f, THR = 20.f;
constexpr int E_MP = 32768;
__device__ __forceinline__ int crow(int r, int hi) { return (r & 3) + 8 * (r >> 2) + 4 * hi; }
__device__ __forceinline__ unsigned cvtpk(float lo, float hi) { f32x2 v = {lo, hi}; bf16x2_t b = __builtin_convertvector(v, bf16x2_t); return __builtin_bit_cast(unsigned, b); }
__device__ __forceinline__ s16x4 vtr(lptr p) { typedef short v4i16_t __attribute__((ext_vector_type(4))); return __builtin_bit_cast(s16x4, __builtin_amdgcn_ds_read_tr16_b64_v4i16((__attribute__((address_space(3))) v4i16_t*)p)); }
__device__ __forceinline__ float xmax32(float v) { return fmaxf(v, __shfl_xor(v, 32)); }

__device__ __forceinline__ void tile_map(f32x16 (&O)[4], float& m, float& l, lptr kb, const bf16x8 (&qf)[4], lptr vb, int rel0, int nvalid,
                                         const __attribute__((address_space(3))) float* btab, __attribute__((address_space(3))) float* wsf, int r32, int hi, int dsel  ) {
    const lptr kl = kb + hi * 1024 + r32 * 16;
    bf16x8 kf[8];
#pragma unroll
    for (int s = 0; s < 4; ++s) { kf[2 * s] = *(const __attribute__((address_space(3))) bf16x8*)(kl + (2 * s) * 1024); kf[2 * s + 1] = *(const __attribute__((address_space(3))) bf16x8*)(kl + (2 * s) * 1024 + 512); }
    f32x16 p0 = {}, p1 = {};
#pragma unroll
    for (int s = 0; s < 4; ++s) { p0 = __builtin_amdgcn_mfma_f32_32x32x16_bf16(kf[2 * s], qf[s], p0, 0, 0, 0); p1 = __builtin_amdgcn_mfma_f32_32x32x16_bf16(kf[2 * s + 1], qf[s], p1, 0, 0, 0); }
    const int lane = r32 + 32 * hi;
    const lptr vp = vb + ((lane >> 4) & 1) * 32 + (lane & 3) * 8 + (4 * hi + ((lane & 15) >> 2)) * 64 + (dsel >= 0 ? dsel * 4096 : 0);
    s16x4 va[8];
#pragma unroll
    for (int ks = 0; ks < 4; ++ks) { va[2 * ks] = vtr(vp + ks * 1024); va[2 * ks + 1] = vtr(vp + ks * 1024 + 512); }
    float cfar = 0.f;
    if (rel0 + 63 < -127) cfar = btab[0];
    else { const __attribute__((address_space(3))) float* bp = btab + (rel0 + 4 * hi - r32 + 223);
#pragma unroll
        for (int r = 0; r < 16; ++r) { p0[r] += bp[(r & 3) + 8 * (r >> 2)]; p1[r] += bp[(r & 3) + 8 * (r >> 2) + 32]; } }
    if (nvalid < 64) {
#pragma unroll
        for (int r = 0; r < 16; ++r) p1[r] = -INFINITY; }
    float mx = fmaxf(p0[0], p1[0]);
#pragma unroll
    for (int r = 1; r < 16; ++r) mx = fmaxf(mx, fmaxf(p0[r], p1[r]));
    mx = xmax32(mx) + cfar;
    if (__any(mx > m + THR)) {
        const float mn = fmaxf(m, mx); const float al = __builtin_amdgcn_exp2f((m - mn) * LOG2E); m = mn; l *= al;
        if (hi == 0) wsf[r32] = al;
        asm volatile("s_waitcnt lgkmcnt(0)" ::: "memory");
#pragma unroll
        for (int r = 0; r < 16; ++r) { const float a = wsf[crow(r, hi)];
#pragma unroll
            for (int d = 0; d < 4; ++d) O[d][r] *= a; }
        asm volatile("s_waitcnt lgkmcnt(0)" ::: "memory");
    }
    const float nm = (cfar - m) * LOG2E; float sum = 0.f;
#pragma unroll
    for (int r = 0; r < 16; ++r) { p0[r] = __builtin_amdgcn_exp2f(__builtin_fmaf(p0[r], LOG2E, nm)); p1[r] = __builtin_amdgcn_exp2f(__builtin_fmaf(p1[r], LOG2E, nm)); sum += p0[r] + p1[r]; }
    l += sum;
    bf16x8 pa[4];
    { const u32x4 w0 = {cvtpk(p0[0], p0[1]), cvtpk(p0[2], p0[3]), cvtpk(p0[4], p0[5]), cvtpk(p0[6], p0[7])}, w1 = {cvtpk(p0[8], p0[9]), cvtpk(p0[10], p0[11]), cvtpk(p0[12], p0[13]), cvtpk(p0[14], p0[15])};
      const u32x4 w2 = {cvtpk(p1[0], p1[1]), cvtpk(p1[2], p1[3]), cvtpk(p1[4], p1[5]), cvtpk(p1[6], p1[7])}, w3 = {cvtpk(p1[8], p1[9]), cvtpk(p1[10], p1[11]), cvtpk(p1[12], p1[13]), cvtpk(p1[14], p1[15])};
      pa[0] = __builtin_bit_cast(bf16x8, w0); pa[1] = __builtin_bit_cast(bf16x8, w1); pa[2] = __builtin_bit_cast(bf16x8, w2); pa[3] = __builtin_bit_cast(bf16x8, w3); }
#define ATT_VF(arr, ks) (bf16x8){arr[2 * (ks)][0], arr[2 * (ks)][1], arr[2 * (ks)][2], arr[2 * (ks)][3], arr[2 * (ks) + 1][0], arr[2 * (ks) + 1][1], arr[2 * (ks) + 1][2], arr[2 * (ks) + 1][3]}
    if (dsel >= 0) {
#pragma unroll
        for (int ks = 0; ks < 4; ++ks) O[0] = __builtin_amdgcn_mfma_f32_32x32x16_bf16(pa[ks], ATT_VF(va, ks), O[0], 0, 0, 0);
    } else {
        s16x4 vb_[8];
#pragma unroll
        for (int d = 0; d < 4; d += 2) {
#pragma unroll
            for (int ks = 0; ks < 4; ++ks) { vb_[2 * ks] = vtr(vp + (d + 1) * 4096 + ks * 1024); vb_[2 * ks + 1] = vtr(vp + (d + 1) * 4096 + ks * 1024 + 512); }
#pragma unroll
            for (int ks = 0; ks < 4; ++ks) O[d] = __builtin_amdgcn_mfma_f32_32x32x16_bf16(pa[ks], ATT_VF(va, ks), O[d], 0, 0, 0);
            if (d + 2 < 4) {
#pragma unroll
                for (int ks = 0; ks < 4; ++ks) { va[2 * ks] = vtr(vp + (d + 2) * 4096 + ks * 1024); va[2 * ks + 1] = vtr(vp + (d + 2) * 4096 + ks * 1024 + 512); } }
#pragma unroll
            for (int ks = 0; ks < 4; ++ks) O[d + 1] = __builtin_amdgcn_mfma_f32_32x32x16_bf16(pa[ks], ATT_VF(vb_, ks), O[d + 1], 0, 0, 0);
        }
    }
#undef ATT_VF
}

__device__ __forceinline__ void attn_prompt_unit(lptr L, int b, int h, int qb, const bf16_t* __restrict__ QD, const bf16_t* __restrict__ KD, const bf16_t* __restrict__ VD, bf16_t* __restrict__ OD,
                                                 const float* __restrict__ g_da, float lam, const __attribute__((address_space(3))) float* btab, __attribute__((address_space(3))) float* wsf_all) {
    int tid = threadIdx.x; asm volatile("" : "+v"(tid));
    const int lane = tid & 63, r32 = lane & 31, hi = lane >> 5; const int wave = __builtin_amdgcn_readfirstlane(tid >> 6);
    const int map = wave >> 2, wq = wave & 3;
    const size_t row0 = (size_t)b * 2048; const int q0 = qb * 128; const int NT = 2 * qb + 2; const int myt = 2 * qb + (wq >> 1) + 1;
    __attribute__((address_space(3))) float* wsf = wsf_all + wave * 64;
    bf16x8 qf[4];
    { const bf16_t* qg = QD + (row0 + q0 + wq * 32 + r32) * 512 + h * 128 + map * 64 + hi * 8;
#pragma unroll
      for (int s = 0; s < 4; ++s) qf[s] = *(const bf16x8*)(qg + 16 * s); }
    const bf16_t* kg = KD + (row0 + lane) * 512 + h * 128 + wave * 8;
    const bf16_t* vg = VD + (row0 + 16 * (wave & 3) + (lane >> 2)) * 512 + h * 128 + (wave >> 2) * 32 + (lane & 3) * 8;
    u32x4 kr0, kr1, vr0, vr1;
#define ATT_LOAD(t) do { const size_t o_ = (size_t)(t) * 64 * 512; kr0 = *(const u32x4*)(kg + o_); kr1 = *(const u32x4*)(kg + o_ + 64); vr0 = *(const u32x4*)(vg + o_); vr1 = *(const u32x4*)(vg + o_ + 64); } while (0)
#define ATT_WRITE(buf) do { const lptr kw_ = L + LK + (buf) * 16384 + wave * 1024 + lane * 16; const lptr vw_ = L + LV + (buf) * 16384 + wave * 1024 + lane * 16; \
        *(__attribute__((address_space(3))) u32x4*)(kw_) = kr0; *(__attribute__((address_space(3))) u32x4*)(kw_ + 8192) = kr1; \
        *(__attribute__((address_space(3))) u32x4*)(vw_) = vr0; *(__attribute__((address_space(3))) u32x4*)(vw_ + 8192) = vr1; } while (0)
    ATT_LOAD(0); ATT_WRITE(0);
    __syncthreads();
    f32x16 O[4] = {}; float m = -INFINITY, l = 0.f;
    for (int t = 0; t < NT; ++t) {
        if (t + 1 < NT) ATT_LOAD(t + 1);
        if (t < myt) { const int buf = t & 1; const int rel0 = 64 * t - (q0 + wq * 32);
            tile_map(O, m, l, L + LK + buf * 16384 + map * 8192, qf, L + LV + buf * 16384, rel0, 64, btab, wsf, r32, hi, -1); }
        if (t + 1 < NT) ATT_WRITE((t + 1) & 1);
        __syncthreads();
    }
#undef ATT_LOAD
#undef ATT_WRITE
    int lz = 0; asm volatile("" : "+v"(lz));
    l += __shfl_xor(l, 32);
    if (hi == 0) wsf[r32] = (map ? lam : 1.f) / l;
    asm volatile("s_waitcnt lgkmcnt(0)" ::: "memory");
    const lptr xb = L + wq * 16384 + lane * 4 + lz;
#pragma unroll
    for (int r = 0; r < 16; ++r) { const float iv = wsf[crow(r, hi)];
#pragma unroll
        for (int d = 0; d < 4; ++d) O[d][r] *= iv; }
    if (map) {
#pragma unroll
        for (int d = 0; d < 4; ++d)
#pragma unroll
            for (int r = 0; r < 16; ++r) *(__attribute__((address_space(3))) float*)(xb + d * 4096 + r * 256) = O[d][r]; }
    __syncthreads();
    if (!map) {
        float gd[4];
#pragma unroll
        for (int d = 0; d < 4; ++d) gd[d] = g_da[32 * d + r32 + lz] * 0.8f;
        bf16_t* ob = OD + (row0 + q0 + wq * 32 + 4 * hi + lz) * 1024 + h * 128 + r32;
#pragma unroll
        for (int r = 0; r < 16; ++r) { float o[4], ss = 0.f;
#pragma unroll
            for (int d = 0; d < 4; ++d) { o[d] = O[d][r] - *(const __attribute__((address_space(3))) float*)(xb + d * 4096 + r * 256); ss += o[d] * o[d]; }
#pragma unroll
            for (int of = 1; of < 32; of <<= 1) ss += __shfl_xor(ss, of);
            const float rs = __builtin_amdgcn_rsqf(ss * (1.f / 128.f) + 1e-6f);
            bf16_t* orow = ob + (size_t)((r & 3) + 8 * (r >> 2)) * 1024;
#pragma unroll
            for (int d = 0; d < 4; ++d) orow[32 * d] = f2bf(o[d] * rs * gd[d]); }
    }
    __syncthreads();
}
__device__ __forceinline__ void attn_sample_unit(lptr L, int b, int h, const bf16_t* __restrict__ QD, const bf16_t* __restrict__ KD, const bf16_t* __restrict__ VD, const float* __restrict__ ck, const float* __restrict__ cv,
                                                 bf16_t* __restrict__ OD, const float* __restrict__ g_da, float lam, const __attribute__((address_space(3))) float* btab, __attribute__((address_space(3))) float* wsf_all) {
    int tid = threadIdx.x; asm volatile("" : "+v"(tid));
    const int lane = tid & 63, r32 = lane & 31, hi = lane >> 5; const int wave = __builtin_amdgcn_readfirstlane(tid >> 6);
    const int map = wave >> 2, dsel = wave & 3;
    const size_t qrow0 = (size_t)E_MP + (size_t)b * 32;
    __attribute__((address_space(3))) float* wsf = wsf_all + wave * 64;
    bf16x8 qf[4];
    { const bf16_t* qg = QD + (qrow0 + r32) * 512 + h * 128 + map * 64 + hi * 8;
#pragma unroll
      for (int s = 0; s < 4; ++s) qf[s] = *(const bf16x8*)(qg + 16 * s); }
    const int key0 = tid >> 5, f4 = tid & 31;
    const float* kc = ck + (((size_t)b * 4096 + key0) * 4 + h) * 128 + 4 * f4; const float* vc = cv + (((size_t)b * 4096 + key0) * 4 + h) * 128 + 4 * f4;
    const int kdst = (f4 >> 1) * 1024 + key0 * 16 + (f4 & 1) * 8;
    const int vdst = ((f4 >> 3) * 4 + (key0 >> 4)) * 1024 + (key0 & 15) * 64 + (f4 & 7) * 8;
    f32x4 kf[4], vf[4];
#define SC_LOAD(t) do { _Pragma("unroll") for (int i = 0; i < 4; ++i) { const size_t o_ = ((size_t)(t) * 64 + 16 * i) * 512; kf[i] = *(const f32x4*)(kc + o_); vf[i] = *(const f32x4*)(vc + o_); } } while (0)
#define SC_WRITE(buf) do { _Pragma("unroll") for (int i = 0; i < 4; ++i) { uint2 a_, b_; a_.x = cvtpk(kf[i][0], kf[i][1]); a_.y = cvtpk(kf[i][2], kf[i][3]); b_.x = cvtpk(vf[i][0], vf[i][1]); b_.y = cvtpk(vf[i][2], vf[i][3]); \
        *(__attribute__((address_space(3))) unsigned long long*)(L + LK + (buf) * 16384 + kdst + 256 * i) = (unsigned long long)a_.x | ((unsigned long long)a_.y << 32); \
        *(__attribute__((address_space(3))) unsigned long long*)(L + LV + (buf) * 16384 + vdst + 1024 * i) = (unsigned long long)b_.x | ((unsigned long long)b_.y << 32); } } while (0)
    SC_LOAD(0); SC_WRITE(0);
    __syncthreads();
    f32x16 O[4] = {}; float m = -INFINITY, l = 0.f;
    u32x4 kr0, kr1, vr0, vr1;
    for (int t = 0; t <= 64; ++t) {
        if (t + 1 < 64) SC_LOAD(t + 1);
        else if (t + 1 == 64) {
            const u32x4 z = {0u, 0u, 0u, 0u};
            const bf16_t* kg = KD + (qrow0 + (lane & 31)) * 512 + h * 128 + wave * 8; kr0 = lane < 32 ? *(const u32x4*)kg : z; kr1 = lane < 32 ? *(const u32x4*)(kg + 64) : z;
            const int vrow = 16 * (wave & 3) + (lane >> 2); const bf16_t* vg = VD + (qrow0 + (vrow & 31)) * 512 + h * 128 + (wave >> 2) * 32 + (lane & 3) * 8;
            vr0 = vrow < 32 ? *(const u32x4*)vg : z; vr1 = vrow < 32 ? *(const u32x4*)(vg + 64) : z; }
        { const int buf = t & 1; tile_map(O, m, l, L + LK + buf * 16384 + map * 8192, qf, L + LV + buf * 16384, 64 * t - 4096, t == 64 ? 32 : 64, btab, wsf, r32, hi, dsel); }
        if (t + 1 < 64) SC_WRITE((t + 1) & 1);
        else if (t + 1 == 64) { const lptr kw_ = L + LK + wave * 1024 + lane * 16; const lptr vw_ = L + LV + wave * 1024 + lane * 16;
            *(__attribute__((address_space(3))) u32x4*)(kw_) = kr0; *(__attribute__((address_space(3))) u32x4*)(kw_ + 8192) = kr1;
            *(__attribute__((address_space(3))) u32x4*)(vw_) = vr0; *(__attribute__((address_space(3))) u32x4*)(vw_ + 8192) = vr1; }
        __syncthreads();
    }
#undef SC_LOAD
#undef SC_WRITE
    int lz = 0; asm volatile("" : "+v"(lz));
    l += __shfl_xor(l, 32);
    if (hi == 0) wsf[r32] = (map ? lam : 1.f) / l;
    asm volatile("s_waitcnt lgkmcnt(0)" ::: "memory");
    const lptr xb = L + dsel * 4096 + lane * 4 + lz;
    __attribute__((address_space(3))) float* pss = (__attribute__((address_space(3))) float*)(L + 16384);
#pragma unroll
    for (int r = 0; r < 16; ++r) O[0][r] *= wsf[crow(r, hi)];
    if (map) {
#pragma unroll
        for (int r = 0; r < 16; ++r) *(__attribute__((address_space(3))) float*)(xb + r * 256) = O[0][r]; }
    __syncthreads();
    float o[16];
    if (!map) {
#pragma unroll
        for (int r = 0; r < 16; ++r) { o[r] = O[0][r] - *(const __attribute__((address_space(3))) float*)(xb + r * 256); float ss = o[r] * o[r];
#pragma unroll
            for (int of = 1; of < 32; of <<= 1) ss += __shfl_xor(ss, of);
            if (r32 == 0) pss[dsel * 32 + crow(r, hi)] = ss; }
    }
    __syncthreads();
    if (!map) {
        const float gd = g_da[32 * dsel + r32 + lz] * 0.8f;
        bf16_t* ob = OD + (qrow0 + 4 * hi + lz) * 1024 + h * 128 + 32 * dsel + r32;
#pragma unroll
        for (int r = 0; r < 16; ++r) { const int q = crow(r, hi); const float ss = (pss[q] + pss[32 + q]) + (pss[64 + q] + pss[96 + q]);
            const float rs = __builtin_amdgcn_rsqf(ss * (1.f / 128.f) + 1e-6f);
            ob[(size_t)((r & 3) + 8 * (r >> 2)) * 1024] = f2bf(o[r] * rs * gd); }
    }
    __syncthreads();
}
constexpr int RQ = 0, RKA = 16384, RKT = 32768, RVT = 49152, RSB = 65536, RATT = 98304, RPSS = 107520;
__device__ __forceinline__ f32x4 bfx4(unsigned lo, unsigned hi) { return (f32x4){__uint_as_float(lo << 16), __uint_as_float(lo & 0xffff0000u), __uint_as_float(hi << 16), __uint_as_float(hi & 0xffff0000u)}; }
__device__ __forceinline__ void ret_unit(lptr L, int sample, int b, int h, const bf16_t* __restrict__ QR, const bf16_t* __restrict__ KR, const bf16_t* __restrict__ VR, const bf16_t* __restrict__ GRS,
                                         const float* __restrict__ s0, const float* __restrict__ g_rt, bf16_t* __restrict__ ORo, float* __restrict__ sout) {
    typedef __attribute__((address_space(3))) unsigned long long* l64p; typedef __attribute__((address_space(3))) u32x4* l128p; typedef __attribute__((address_space(3))) float* lfp;
    int tid = threadIdx.x; asm volatile("" : "+v"(tid));
    const int lane = tid & 63, r32 = lane & 31, hi = lane >> 5; const int wave = __builtin_amdgcn_readfirstlane(tid >> 6);
    const int ib = wave >> 2, jb = wave & 3;
    const int c = sample ? 32 : 64, nch = sample ? 1 : 32;
    const size_t row0 = sample ? (size_t)E_MP + (size_t)b * 32 : (size_t)b * 2048;
    const float lg = __builtin_log2f(1.f - __builtin_amdgcn_exp2f(-5.f - (float)h));
    const float dec_c = __builtin_amdgcn_exp2f(lg * (float)c);
    f32x16 S2[2];
#pragma unroll
    for (int k = 0; k < 2; ++k)
#pragma unroll
        for (int r = 0; r < 16; ++r) S2[k][r] = sample ? s0[(((size_t)b * 4 + h) * 128 + 32 * (2 * ib + k) + crow(r, hi)) * 128 + 32 * jb + r32] : 0.f;
    const lptr sbw = L + RSB + (8 * ib) * 2048 + (32 * jb + r32) * 16 + 8 * hi;
#define RET_WRITE_SB() do { _Pragma("unroll") for (int k = 0; k < 2; ++k) _Pragma("unroll") for (int g = 0; g < 4; ++g) { \
        const unsigned lo_ = cvtpk(S2[k][4 * g], S2[k][4 * g + 1]), hi_ = cvtpk(S2[k][4 * g + 2], S2[k][4 * g + 3]); *(l64p)(sbw + (4 * k + g) * 2048) = (unsigned long long)lo_ | ((unsigned long long)hi_ << 32); } } while (0)
    RET_WRITE_SB();
    const bool cvalid = lane < c; const int trow = 16 * (wave & 3) + (lane >> 2); const bool tvalid = trow < c;
    const size_t coff = (row0 + (cvalid ? lane : 0)) * 512 + h * 128 + wave * 8; const size_t toff = (row0 + (tvalid ? trow : 0)) * 512 + h * 128 + (wave >> 2) * 32 + (lane & 3) * 8;
    const float dk_t = tvalid ? __builtin_amdgcn_exp2f(lg * (float)(c - 1 - trow)) : 0.f;
    u32x4 q0, q1, k0, k1, t0, t1, v0, v1; const u32x4 z4 = {0u, 0u, 0u, 0u};
#define RET_LOAD(ci) do { const size_t o_ = (size_t)(ci) * 64 * 512; q0 = cvalid ? *(const u32x4*)(QR + coff + o_) : z4; q1 = cvalid ? *(const u32x4*)(QR + coff + o_ + 64) : z4; \
        k0 = cvalid ? *(const u32x4*)(KR + coff + o_) : z4; k1 = cvalid ? *(const u32x4*)(KR + coff + o_ + 64) : z4; \
        t0 = *(const u32x4*)(KR + toff + o_); t1 = *(const u32x4*)(KR + toff + o_ + 64); v0 = tvalid ? *(const u32x4*)(VR + toff + o_) : z4; v1 = tvalid ? *(const u32x4*)(VR + toff + o_ + 64) : z4; } while (0)
#define RET_SCALE(t) do { const f32x4 a_ = bfx4(t.x, t.y) * dk_t, b_ = bfx4(t.z, t.w) * dk_t; t.x = cvtpk(a_[0], a_[1]); t.y = cvtpk(a_[2], a_[3]); t.z = cvtpk(b_[0], b_[1]); t.w = cvtpk(b_[2], b_[3]); } while (0)
#define RET_WRITE() do { RET_SCALE(t0); RET_SCALE(t1); const lptr cw_ = L + wave * 1024 + lane * 16; \
        *(l128p)(cw_ + RQ) = q0; *(l128p)(cw_ + RQ + 8192) = q1; *(l128p)(cw_ + RKA) = k0; *(l128p)(cw_ + RKA + 8192) = k1; \
        *(l128p)(cw_ + RKT) = t0; *(l128p)(cw_ + RKT + 8192) = t1; *(l128p)(cw_ + RVT) = v0; *(l128p)(cw_ + RVT + 8192) = v1; } while (0)
    RET_LOAD(0); RET_WRITE();
    __syncthreads();
    const float dqb = lg * (float)(32 * ib + 4 * hi + 1);
    const lptr qa = L + RQ + hi * 1024 + (32 * ib + r32) * 16, sbr = L + RSB + hi * 2048 + (32 * jb + r32) * 16;
    const lptr trb = L + ((lane >> 4) & 1) * 32 + (lane & 3) * 8 + (4 * hi + ((lane & 15) >> 2)) * 64;
    const lptr attr = L + RATT + (32 * ib + r32) * 144 + 8 * hi;
    const float grt = g_rt[32 * jb + r32];
    for (int ci = 0; ci < nch; ++ci) {
        if (ci + 1 < nch) RET_LOAD(ci + 1);
        int lz = 0; asm volatile("" : "+v"(lz));
        unsigned short gr[16];
#pragma unroll
        for (int r = 0; r < 16; ++r) { const int tok = 32 * ib + crow(r, hi); gr[r] = GRS[(row0 + (size_t)ci * 64 + (tok < c ? tok : 0)) * 512 + h * 128 + 32 * jb + r32]; }
        f32x16 oS = {};
#pragma unroll
        for (int s = 0; s < 8; ++s) { const bf16x8 a_ = *(const __attribute__((address_space(3))) bf16x8*)(qa + 2 * s * 1024), b_ = *(const __attribute__((address_space(3))) bf16x8*)(sbr + 2 * s * 2048);
            oS = __builtin_amdgcn_mfma_f32_32x32x16_bf16(a_, b_, oS, 0, 0, 0); }
        if (jb < 2 && !(ib == 0 && jb == 1)) {
            f32x16 at = {}; const lptr ka = L + RKA + hi * 1024 + (32 * jb + r32) * 16;
#pragma unroll
            for (int s = 0; s < 8; ++s) { const bf16x8 a_ = *(const __attribute__((address_space(3))) bf16x8*)(ka + 2 * s * 1024), b_ = *(const __attribute__((address_space(3))) bf16x8*)(qa + 2 * s * 1024);
                at = __builtin_amdgcn_mfma_f32_32x32x16_bf16(a_, b_, at, 0, 0, 0); }
            const int i = 32 * ib + r32;
#pragma unroll
            for (int g = 0; g < 4; ++g) { float w_[4];
#pragma unroll
                for (int e = 0; e < 4; ++e) { const int j = 32 * jb + 8 * g + 4 * hi + e; w_[e] = i >= j ? at[4 * g + e] * __builtin_amdgcn_exp2f(lg * (float)(i - j + lz)) : 0.f; }
                *(l64p)(L + RATT + i * 144 + (32 * jb + 8 * g + 4 * hi) * 2) = (unsigned long long)cvtpk(w_[0], w_[1]) | ((unsigned long long)cvtpk(w_[2], w_[3]) << 32); }
        }
        __syncthreads();
        f32x16 oI = {};
#pragma unroll
        for (int ks = 0; ks < 4; ++ks) { if (ib == 0 && ks >= 2) break;
            const s16x4 a0 = *(const __attribute__((address_space(3))) s16x4*)(attr + 32 * ks), a1 = *(const __attribute__((address_space(3))) s16x4*)(attr + 32 * ks + 16);
            const s16x4 lo = vtr(trb + RVT + jb * 4096 + ks * 1024), hh = vtr(trb + RVT + jb * 4096 + ks * 1024 + 512);
            const bf16x8 af = {a0[0], a0[1], a0[2], a0[3], a1[0], a1[1], a1[2], a1[3]}, vf = {lo[0], lo[1], lo[2], lo[3], hh[0], hh[1], hh[2], hh[3]};
            oI = __builtin_amdgcn_mfma_f32_32x32x16_bf16(af, vf, oI, 0, 0, 0); }
#pragma unroll
        for (int k = 0; k < 2; ++k) {
#pragma unroll
            for (int r = 0; r < 16; ++r) S2[k][r] *= dec_c;
#pragma unroll
            for (int ks = 0; ks < 4; ++ks) {
                const s16x4 kl = vtr(trb + RKT + (2 * ib + k) * 4096 + ks * 1024), kh = vtr(trb + RKT + (2 * ib + k) * 4096 + ks * 1024 + 512);
                const s16x4 lo = vtr(trb + RVT + jb * 4096 + ks * 1024), hh = vtr(trb + RVT + jb * 4096 + ks * 1024 + 512);
                const bf16x8 kf = {kl[0], kl[1], kl[2], kl[3], kh[0], kh[1], kh[2], kh[3]}, vf = {lo[0], lo[1], lo[2], lo[3], hh[0], hh[1], hh[2], hh[3]};
                S2[k] = __builtin_amdgcn_mfma_f32_32x32x16_bf16(kf, vf, S2[k], 0, 0, 0); } }
        RET_WRITE_SB();
        float o[16];
#pragma unroll
        for (int r = 0; r < 16; ++r) { o[r] = oI[r] + oS[r] * __builtin_amdgcn_exp2f(dqb + lg * (float)((r & 3) + 8 * (r >> 2) + lz)); float ss = o[r] * o[r];
#pragma unroll
            for (int of = 1; of < 32; of <<= 1) ss += __shfl_xor(ss, of);
            if (r32 == 0) *(lfp)(L + RPSS + (jb * 64 + 32 * ib + crow(r, hi)) * 4) = ss; }
        __syncthreads();
        { bf16_t* ob = ORo + (row0 + (size_t)ci * 64 + 32 * ib + 4 * hi) * 1024 + h * 128 + 32 * jb + r32; const lfp ps = (lfp)(L + RPSS + (32 * ib + 4 * hi) * 4);
#pragma unroll
          for (int r = 0; r < 16; ++r) { const int to = (r & 3) + 8 * (r >> 2); const float tot = (ps[to] + ps[64 + to]) + (ps[128 + to] + ps[192 + to]);
              const float rs = __builtin_amdgcn_rsqf(tot * (1.f / 128.f) + 1e-6f);
              if (32 * ib + 4 * hi + to < c) ob[(size_t)to * 1024] = f2bf(o[r] * rs * grt * bf2f(gr[r])); } }
        if (ci + 1 < nch) RET_WRITE();
        __syncthreads();
    }
#undef RET_LOAD
#undef RET_SCALE
#undef RET_WRITE
#undef RET_WRITE_SB
#pragma unroll
    for (int k = 0; k < 2; ++k)
#pragma unroll
        for (int r = 0; r < 16; ++r) sout[(((size_t)b * 4 + h) * 128 + 32 * (2 * ib + k) + crow(r, hi)) * 128 + 32 * jb + r32] = S2[k][r];
}
}

constexpr int NWAVES = 8;
constexpr int RING_BYTES = 131072, LDSCTL_OFF = RING_BYTES, MISC_OFF = LDSCTL_OFF + 320, LDS_BYTES = 147456;
constexpr size_t al256(size_t x) { return (x + 255) & ~(size_t)255; }
constexpr size_t WS_CTL = 0, CTL_ZERO_BYTES = 1u << 20;
constexpr size_t WS_BT_IN = CTL_ZERO_BYTES;
constexpr size_t WS_BT_BD = WS_BT_IN + (size_t)DIN * D * 2;
constexpr size_t WS_BT_BR = WS_BT_BD + (size_t)D * 512 * 2;
constexpr size_t WS_BT_O = WS_BT_BR + (size_t)D * 512 * 2;
constexpr size_t WS_BT_GU = WS_BT_O + (size_t)D * D * 2;
constexpr size_t WS_BT_D = WS_BT_GU + (size_t)DIN * D * 2;
constexpr size_t WS_BT_PE = WS_BT_D + (size_t)D * DFF * 2;
constexpr size_t WS_BT_PG = WS_BT_PE + (size_t)D * PE * 2;
constexpr size_t WS_ROT = WS_BT_PG + (size_t)D * D * 2;
constexpr size_t WS_XN = al256(WS_ROT + (size_t)2080 * 64 * 8);
constexpr size_t WS_PEB = WS_XN + (size_t)M * D * 2;
constexpr size_t WS_REGB = WS_PEB + (size_t)M * PE * 2;
constexpr size_t WS_OD = WS_REGB + (size_t)M * DIN * 2;
constexpr size_t WS_OR = WS_OD + (size_t)M * 512 * 2;
constexpr size_t WS_H1 = WS_OR + (size_t)M * 512 * 2;
constexpr size_t WS_REGA = WS_H1 + (size_t)M * D * 4;
constexpr size_t WS_END = WS_REGA + (size_t)M * DIN * 2;

#define GAS __attribute__((address_space(1)))
#define LAS __attribute__((address_space(3)))
typedef unsigned v4u __attribute__((ext_vector_type(4)));
typedef GAS unsigned gu32;
#define RLX_AGENT __ATOMIC_RELAXED, __HIP_MEMORY_SCOPE_AGENT
#define LDS_WAIT() asm volatile("s_waitcnt lgkmcnt(0)" ::: "memory")
#define VM_WAIT() asm volatile("s_waitcnt vmcnt(0)" ::: "memory")
__device__ __forceinline__ unsigned pk2(float lo, float hi) { return (unsigned)f2bf(lo) | ((unsigned)f2bf(hi) << 16); }

struct Args { const float* in[31]; float* out; unsigned char* ws; int ph_lo, ph_hi, li, pad; };

__device__ __forceinline__ void p0_transpose_item(const float* W, int K, int N, bf16_t* WT, int dst_row0, const float* gk, LAS float* scr, int k0, int n0, int lane, int ldk = 0, int koff = 0) {
    if (ldk == 0) ldk = K;
#pragma unroll 8
    for (int i = 0; i < 32; ++i) { const int kk = 2 * i + (lane >> 5); float w = W[(size_t)(k0 + kk) * N + n0 + (lane & 31)]; if (gk) w *= gk[k0 + kk]; scr[kk * 33 + (lane & 31)] = w; }
    LDS_WAIT(); asm volatile("" ::: "memory");
    const int c = lane & 7;
#pragma unroll
    for (int j = 0; j < 4; ++j) { const int n = (lane >> 3) + 8 * j; const LAS float* s = scr + (8 * c) * 33 + n;
        v4u o; o.x = pk2(s[0 * 33], s[1 * 33]); o.y = pk2(s[2 * 33], s[3 * 33]); o.z = pk2(s[4 * 33], s[5 * 33]); o.w = pk2(s[6 * 33], s[7 * 33]);
        *(v4u*)(WT + (size_t)(dst_row0 + n) * ldk + koff + k0 + 8 * c) = o; }
    LDS_WAIT(); asm volatile("" ::: "memory");
}
__device__ __forceinline__ int btin_dst(int nb) {
    const int tile = nb >> 3, o = nb & 7; int ct;
    if (tile < 4) ct = 128 * (o & 1) + 32 * (o >> 1);
    else if (tile >= 6 && tile < 10) ct = 128 * ((o >> 1) & 1) + 32 * (2 * (o >> 2) + (o & 1));
    else ct = 32 * o;
    return tile * 256 + ct;
}
__device__ __forceinline__ float wave_sum(float v) {
#pragma unroll
    for (int o = 1; o < 64; o <<= 1) v += __shfl_xor(v, o);
    return v;
}

constexpr int CW_Q = 2048;
constexpr int CW_BAR = 4096;
#define XB_TMO      128
#define XB_XCNT(j)  (256  + 64 * (j))
#define XB_XSUB(j)  (1280 + 64 * (j))
#define XB_XGEN(j)  (2304 + 64 * (j))
#define XB_TOP      3328
#define XB_TOPGEN   3392
#define XCD_BAR_WORDS 3456
#define XB_SPIN_CAP (1u << 18)

__device__ __forceinline__ unsigned xb_ld(unsigned* p)              { return __hip_atomic_load(p, __ATOMIC_RELAXED, __HIP_MEMORY_SCOPE_AGENT); }
__device__ __forceinline__ unsigned xb_add(unsigned* p, unsigned v) { return __hip_atomic_fetch_add(p, v, __ATOMIC_RELAXED, __HIP_MEMORY_SCOPE_AGENT); }
__device__ __forceinline__ unsigned xb_xcc_id() { return (unsigned)__builtin_amdgcn_s_getreg((3 << 11) | 20) & 0xFu; }
#define XB_SPIN(cond, bar) do { unsigned _sp = 0; while (cond) { __builtin_amdgcn_s_sleep(1); \
    if ((++_sp & 255u) == 0u) { if (xb_ld(&(bar)[XB_TMO])) break; if (_sp > XB_SPIN_CAP) { atomicAdd(&(bar)[XB_TMO], 1u); break; } } } } while (0)

struct XcdBarrier {
    unsigned* bar; unsigned x;
    volatile LAS unsigned* st;
};

__device__ __forceinline__ XcdBarrier xcd_barrier_post(unsigned* bar, volatile LAS unsigned* st) {
    XcdBarrier b; b.bar = bar; b.x = xb_xcc_id(); b.st = st;
    if (threadIdx.x == 0) (void)xb_add(&bar[XB_XCNT(b.x)], 1u);
    return b;
}
__device__ __forceinline__ void xcd_barrier_complete(unsigned* bar, unsigned x, unsigned& nloc, unsigned& nx) {
    const unsigned G = gridDim.x * gridDim.y * gridDim.z;
    unsigned sum, cnt, mine, sp = 0u;
    for (;;) {
        sum = 0u; cnt = 0u; mine = 0u;
#pragma unroll
        for (unsigned j = 0; j < 16; ++j) { const unsigned c = xb_ld(&bar[XB_XCNT(j)]); sum += c; cnt += (c > 0u) ? 1u : 0u; mine = (j == x) ? c : mine; }
        if (sum == G) break;
        __builtin_amdgcn_s_sleep(1);
        if ((++sp & 255u) == 0u) { if (xb_ld(&bar[XB_TMO])) break; if (sp > XB_SPIN_CAP) { atomicAdd(&bar[XB_TMO], 1u); break; } }
    }
    nloc = mine > 0u ? mine : 1u; nx = cnt > 0u ? cnt : 1u;
}

__device__ __forceinline__ void xcd_barrier(const XcdBarrier& b) {
    asm volatile("s_waitcnt vmcnt(0)" ::: "memory");
    __syncthreads();
    if (threadIdx.x == 0) {
        unsigned* bar = b.bar;
        __builtin_amdgcn_s_waitcnt(0);
        unsigned nloc = b.st[0], nx = b.st[1];
        if (nloc == 0u) { xcd_barrier_complete(bar, b.x, nloc, nx); b.st[0] = nloc; b.st[1] = nx; }
        const unsigned old = xb_add(&bar[XB_XSUB(b.x)], 1u);
        const unsigned gen = old / nloc;
        if (old + 1u == (gen + 1u) * nloc) {
            __builtin_amdgcn_fence(__ATOMIC_RELEASE, "agent");
            asm volatile("s_waitcnt vmcnt(0)" ::: "memory");
            const unsigned og = xb_add(&bar[XB_TOP], 1u);
            const unsigned tg = og / nx;
            if (og + 1u == (tg + 1u) * nx) xb_add(&bar[XB_TOPGEN], 1u);
            else XB_SPIN(xb_ld(&bar[XB_TOPGEN]) == tg, bar);
            __builtin_amdgcn_fence(__ATOMIC_ACQUIRE, "agent");
            xb_add(&bar[XB_XGEN(b.x)], 1u);
            asm volatile("s_waitcnt vmcnt(0)" ::: "memory");
        } else {
            XB_SPIN(xb_ld(&bar[XB_XGEN(b.x)]) == gen, bar);
            __builtin_amdgcn_fence(__ATOMIC_ACQUIRE, "agent");
            asm volatile("s_waitcnt vmcnt(0)" ::: "memory");
        }
    }
    __syncthreads();
}

__global__ void __launch_bounds__(NWAVES * 64, 2) mk_fwd(Args args) {
    extern __shared__ __attribute__((aligned(16))) unsigned char lds[];
    LAS unsigned char* L = (LAS unsigned char*)lds;
    const int tid = threadIdx.x, lane = tid & 63, wave = __builtin_amdgcn_readfirstlane(tid >> 6);
    const int G = gridDim.x, bx = blockIdx.x; const int vcu = (G % 8 == 0) ? (bx % 8) * (G / 8) + bx / 8 : bx;
    unsigned char* ws = args.ws;
    const int lo = args.ph_lo, hi = args.ph_hi;
#define IN(k) (lo <= (k) && (k) < hi)
#define BOTH(k, k2) (IN(k) && IN(k2))
    for (int u_ = tid; u_ < (LDS_BYTES - LDSCTL_OFF) / 4; u_ += NWAVES * 64) ((LAS unsigned*)(L + LDSCTL_OFF))[u_] = 0u;
    __syncthreads();
    XcdBarrier bar = xcd_barrier_post((unsigned*)(ws + WS_CTL) + CW_BAR + args.li * XCD_BAR_WORDS, (volatile LAS unsigned*)(L + MISC_OFF) + 8);
#define GRID_BAR() xcd_barrier(bar)
    const float* x_p = args.in[0]; const float* x_s = args.in[1]; const float* p_p = args.in[2]; const float* p_s = args.in[3];
    bf16_t* XN = (bf16_t*)(ws + WS_XN); bf16_t* PEB = (bf16_t*)(ws + WS_PEB); float* ROT = (float*)(ws + WS_ROT);
    bf16_t* QD = (bf16_t*)(ws + WS_REGB); bf16_t* KD = QD + (size_t)M * 512; bf16_t* VD = KD + (size_t)M * 512; bf16_t* QR = VD + (size_t)M * 512; bf16_t* KR = QR + (size_t)M * 512;
    bf16_t* VR = KR + (size_t)M * 512; bf16_t* GRS = VR + (size_t)M * 512; bf16_t* GD = GRS + (size_t)M * 512; bf16_t* GT = GD + (size_t)M * D;
    float* out = args.out;
    float* k_p = out + (size_t)M * D; float* v_p = k_p + (size_t)MP * 512; float* r_p = v_p + (size_t)MP * 512; float* c_p = r_p + (size_t)16 * 4 * 128 * 128;
    float* k_s = c_p + (size_t)16 * 2 * DFF; float* v_s = k_s + (size_t)MS * 512;

    if (IN(0)) {
        LAS float* scr = (LAS float*)(L + wave * 16384);
        const int gw = vcu * NWAVES + wave, NGW = G * NWAVES;
        const float* w_in = args.in[10]; const float* w_bd = args.in[19]; const float* w_br = args.in[20]; const float* w_o = args.in[21]; const float* g_ffn = args.in[22];
        const float* w_g = args.in[23]; const float* w_u = args.in[24]; const float* w_d = args.in[27]; const float* g_pe = args.in[28]; const float* w_pe = args.in[29]; const float* w_pg = args.in[30];
        constexpr int I_IN = 16 * 176, I_BD = 8 * 32, I_O = 16 * 32, I_G = 16 * 88, I_D = 44 * 32, I_PE = 4 * 32;
        constexpr int NITEMS = I_IN + 2 * I_BD + I_O + 2 * I_G + I_D + I_PE + I_O;
        for (int it = gw; it < NITEMS; it += NGW) {
            int r = it;
            if (r < I_IN) { const int kb = r / 176, nb = r % 176; p0_transpose_item(w_in, D, DIN, (bf16_t*)(ws + WS_BT_IN), btin_dst(nb), nullptr, scr, 64 * kb, 32 * nb, lane); continue; } r -= I_IN;
            if (r < I_BD) { const int kb = r / 32, nb = r % 32; p0_transpose_item(w_bd, 512, D, (bf16_t*)(ws + WS_BT_BD), 32 * nb, nullptr, scr, 64 * kb, 32 * nb, lane, 1024, 0); continue; } r -= I_BD;
            if (r < I_BD) { const int kb = r / 32, nb = r % 32; p0_transpose_item(w_br, 512, D, (bf16_t*)(ws + WS_BT_BD), 32 * nb, nullptr, scr, 64 * kb, 32 * nb, lane, 1024, 512); continue; } r -= I_BD;
            if (r < I_O) { const int kb = r / 32, nb = r % 32; p0_transpose_item(w_o, D, D, (bf16_t*)(ws + WS_BT_O), 32 * nb, nullptr, scr, 64 * kb, 32 * nb, lane); continue; } r -= I_O;
            if (r < I_G) { const int kb = r / 88, nb = r % 88; p0_transpose_item(w_g, D, DFF, (bf16_t*)(ws + WS_BT_GU), 256 * (nb >> 2) + 32 * (nb & 3), g_ffn, scr, 64 * kb, 32 * nb, lane); continue; } r -= I_G;
            if (r < I_G) { const int kb = r / 88, nb = r % 88; p0_transpose_item(w_u, D, DFF, (bf16_t*)(ws + WS_BT_GU), 256 * (nb >> 2) + 128 + 32 * (nb & 3), g_ffn, scr, 64 * kb, 32 * nb, lane); continue; } r -= I_G;
            if (r < I_D) { const int kb = r / 32, nb = r % 32; p0_transpose_item(w_d, DFF, D, (bf16_t*)(ws + WS_BT_D), 32 * nb, nullptr, scr, 64 * kb, 32 * nb, lane); continue; } r -= I_D;
            if (r < I_PE) { const int kb = r / 32, nb = r % 32; p0_transpose_item(w_pe, PE, D, (bf16_t*)(ws + WS_BT_PE), 32 * nb, nullptr, scr, 64 * kb, 32 * nb, lane); continue; } r -= I_PE;
            { const int kb = r / 32, nb = r % 32; p0_transpose_item(w_pg, D, D, (bf16_t*)(ws + WS_BT_PG), 32 * nb, g_pe, scr, 64 * kb, 32 * nb, lane); }
        }
        const float* g_mix = args.in[9];
        for (int m = gw; m < M; m += NGW) {
            const float* xr = m < MP ? x_p + (size_t)m * D : x_s + (size_t)(m - MP) * D;
            f32x4 v[4]; float ss = 0.f;
#pragma unroll
            for (int j = 0; j < 4; ++j) { v[j] = ((const f32x4*)xr)[lane + 64 * j]; ss += (v[j][0] * v[j][0] + v[j][1] * v[j][1]) + (v[j][2] * v[j][2] + v[j][3] * v[j][3]); }
            const float rstd = rsqrtf(wave_sum(ss) * (1.f / D) + EPS);
#pragma unroll
            for (int j = 0; j < 4; ++j) { const f32x4 gv = ((const f32x4*)g_mix)[lane + 64 * j]; const f32x4 o = v[j] * rstd * gv;
                uint2 w; w.x = pk2(o[0], o[1]); w.y = pk2(o[2], o[3]); ((uint2*)(XN + (size_t)m * D))[lane + 64 * j] = w; }
        }
        for (size_t i = (size_t)gw * 64 + lane; i < (size_t)M * PE / 4; i += (size_t)NGW * 64) {
            const f32x4 v = i < (size_t)MP * PE / 4 ? ((const f32x4*)p_p)[i] : ((const f32x4*)p_s)[i - (size_t)MP * PE / 4];
            uint2 w; w.x = pk2(v[0], v[1]); w.y = pk2(v[2], v[3]); ((uint2*)PEB)[i] = w; }
        for (int i = gw * 64 + lane; i < 2080 * 64; i += NGW * 64) { const int pidx = i >> 6, d = i & 63; const int pos = pidx < 2048 ? pidx : PAST + (pidx - 2048);
            const float inv = powf(10000.f, -(float)d / 64.f); const float ang = (float)pos * inv; float sn, cs; sincosf(ang, &sn, &cs); ROT[2 * i] = cs; ROT[2 * i + 1] = sn; }
    }
    if (BOTH(0, 1)) GRID_BAR();
    if (IN(1)) {
        pg8::Gemm g{XN, (const bf16_t*)(ws + WS_BT_IN), M, DIN, D}; pg8::StaticOrder S; S.init(M, DIN, G, bx);
        pg8::EpiIn E{QD, KD, VD, QR, KR, VR, GRS, GD, GT, k_p, k_s, v_p, v_s, args.in[11], args.in[12], ROT};
        pg8::gemm_phase<pg8::EpiIn, pg8::StaticOrder, true, true>(L, g, S, E);
    }
    bf16_t* OD = (bf16_t*)(ws + WS_OD); bf16_t* ORb = OD + 512;
    float* T1 = (float*)(ws + WS_REGB); bf16_t* MIX = (bf16_t*)(ws + WS_REGB + (size_t)M * D * 4);
    bf16_t* ACT = (bf16_t*)(ws + WS_REGB); float* HEADP = (float*)(ws + WS_REGB + (size_t)200 * 1048576); float* HEADU = HEADP + (size_t)512 * 2 * DFF; float* TAIL = HEADU + (size_t)512 * 2 * DFF;
    bf16_t* TPEB = (bf16_t*)(ws + WS_H1); float* SS1 = (float*)(ws + WS_OD); float* SS2 = SS1 + (size_t)1048576;
    float* y = out; float* c_s = v_s + (size_t)MS * 512 + (size_t)32 * 4 * 128 * 128;
    LAS float* tab = (LAS float*)(L + LDSCTL_OFF + 1024);
    if (BOTH(1, 2)) GRID_BAR();
    if (IN(2)) {
        LAS float* btab = (LAS float*)(L + LDSCTL_OFF + 2048); LAS float* wsf = (LAS float*)(L + LDSCTL_OFF + 3328);
        volatile LAS unsigned* qslot = (volatile LAS unsigned*)(L + LDSCTL_OFF + 64);
        unsigned* qctr = (unsigned*)(ws + WS_CTL) + CW_Q;
        float* r_s = v_s + (size_t)MS * 512;
        float lam; { float a_ = 0.f, c_ = 0.f; for (int i = 0; i < 64; ++i) { a_ += args.in[13][i] * args.in[14][i]; c_ += args.in[15][i] * args.in[16][i]; } lam = __expf(a_) - __expf(c_) + LAM_INIT; }
        for (;;) {
            if (tid == 0) *qslot = __hip_atomic_fetch_add(qctr, 1u, __ATOMIC_RELAXED, __HIP_MEMORY_SCOPE_AGENT);
            __syncthreads();
            const int u_ = (int)*qslot;
            if (u_ >= 1344) break;
            if (u_ < 64) att::ret_unit(L, 0, u_ >> 2, u_ & 3, QR, KR, VR, GRS, args.in[6], args.in[18], ORb, r_p);
            else if (u_ < 192) { const int v_ = u_ - 64; const int b = v_ >> 2, h = v_ & 3;
                if (tid < 288) btab[tid] = args.in[8][t5_bucket(tid - 223) * 4 + h];
                att::attn_sample_unit(L, b, h, QD, KD, VD, args.in[4], args.in[5], OD, args.in[17], lam, btab, wsf); }
            else if (u_ < 1216) { const int v_ = u_ - 192; const int qb = 15 - (v_ >> 6), bh = v_ & 63; const int b = bh >> 2, h = bh & 3;
                if (tid < 288) btab[tid] = args.in[8][t5_bucket(tid - 223) * 4 + h];
                att::attn_prompt_unit(L, b, h, qb, QD, KD, VD, OD, args.in[17], lam, btab, wsf); }
            else { const int v_ = u_ - 1216; att::ret_unit(L, 1, v_ >> 2, v_ & 3, QR, KR, VR, GRS, args.in[6], args.in[18], ORb, r_s); }
            __syncthreads();
        }
    }
    if (BOTH(2, 3)) GRID_BAR();
    if (IN(3)) {
        int kmx = D; asm volatile("" : "+s"(kmx));
        pg8::Gemm g{OD, (const bf16_t*)(ws + WS_BT_BD), M, D, kmx}; pg8::StaticOrder S; S.init(M, D, G, bx); pg8::EpiMixMerged E{GD, GT, MIX};
        pg8::gemm_phase<pg8::EpiMixMerged, pg8::StaticOrder, true, true>(L, g, S, E);
    }
    if (BOTH(3, 4)) GRID_BAR();
    if (IN(4)) {
        pg8::Gemm g{MIX, (const bf16_t*)(ws + WS_BT_O), M, D, D}; pg8::StaticOrder S; S.init(M, D, G, bx);
        pg8::EpiResNorm E{x_p, x_s, XN, SS1};
        pg8::gemm_phase<pg8::EpiResNorm, pg8::StaticOrder, true, true>(L, g, S, E);
    }
    if (BOTH(4, 5)) GRID_BAR();
    if (IN(5)) {
        pg8::Gemm g{XN, (const bf16_t*)(ws + WS_BT_GU), M, DIN, D}; pg8::StaticOrder S; S.init(M, DIN, G, bx);
        pg8::EpiGU E{SS1, args.in[7], args.in[25], args.in[26], ACT, HEADP, HEADU, TAIL, c_p, c_s, tab};
        pg8::gemm_phase<pg8::EpiGU, pg8::StaticOrder, true, true>(L, g, S, E);
    }
    if (BOTH(5, 6)) GRID_BAR();
    if (IN(6)) {
        const float* cw = args.in[25];
        for (int i = bx * (NWAVES * 64) + tid; i < 512 * 2 * (DFF / 4); i += G * NWAVES * 64) {
            const int j4 = i % (DFF / 4), rr = (i / (DFF / 4)) & 1, grp = i / (2 * (DFF / 4));
            const size_t o = ((size_t)grp * 2 + rr) * DFF + 4 * j4;
            f32x4 gc = *(const f32x4*)(HEADP + o); const f32x4 uu = *(const f32x4*)(HEADU + o);
            if (grp & 31) { const f32x4 t0 = *(const f32x4*)(TAIL + ((size_t)(grp - 1) * 2) * DFF + 4 * j4), t1 = *(const f32x4*)(TAIL + ((size_t)(grp - 1) * 2 + 1) * DFF + 4 * j4);
                const f32x4 w0 = *(const f32x4*)(cw + 4 * j4), w1 = *(const f32x4*)(cw + DFF + 4 * j4);
                gc = rr == 0 ? gc + w0 * t0 + w1 * t1 : gc + w0 * t1; }
            f32x4 a;
#pragma unroll
            for (int k = 0; k < 4; ++k) a[k] = pg8::gelu_t(gc[k]) * uu[k];
            uint2 w; w.x = pg8::cvtpk(a[0], a[1]); w.y = pg8::cvtpk(a[2], a[3]);
            *(uint2*)(ACT + (size_t)(grp * 64 + rr) * DFF + 4 * j4) = w;
        }
    }
    if (BOTH(6, 7)) GRID_BAR();
    if (IN(7)) {
        pg8::Gemm g{ACT, (const bf16_t*)(ws + WS_BT_D), M, D, DFF}; pg8::StaticOrder S; S.init(M, D, G, bx);
        pg8::EpiResNormB E{XN, SS2};
        pg8::gemm_phase<pg8::EpiResNormB, pg8::StaticOrder, true, true>(L, g, S, E);
    }
    if (BOTH(7, 8)) GRID_BAR();
    if (IN(8)) {
        { int kpe = PE; asm volatile("" : "+s"(kpe));
          pg8::Gemm g{PEB, (const bf16_t*)(ws + WS_BT_PE), M, D, kpe}; pg8::StaticOrder S; S.init(M, D, G, bx); pg8::EpiStoreB16 E{TPEB};
          pg8::gemm_phase<pg8::EpiStoreB16, pg8::StaticOrder, true, true>(L, g, S, E); }
        { pg8::Gemm g{XN, (const bf16_t*)(ws + WS_BT_PG), M, D, D}; pg8::StaticOrder S; S.init(M, D, G, bx); pg8::EpiFinalY E{SS2, TPEB, XN, y, tab};
          pg8::gemm_phase<pg8::EpiFinalY, pg8::StaticOrder, true, true>(L, g, S, E); }
    }
#undef IN
#undef BOTH
#undef GRID_BAR
}
extern "C" void kernel_launch(void* const* d_in, const int* in_sizes, int n_in, void* d_out, int out_size, void* d_ws, size_t ws_size, hipStream_t stream) {
    const float* x_p = (const float*)d_in[0]; const float* x_s = (const float*)d_in[1];
    const float* cache_k = (const float*)d_in[4]; const float* cache_v = (const float*)d_in[5]; const float* state_ret = (const float*)d_in[6]; const float* state_conv = (const float*)d_in[7];
    const float* rel_bias = (const float*)d_in[8];
    const float* lq1 = (const float*)d_in[13]; const float* lk1 = (const float*)d_in[14]; const float* lq2 = (const float*)d_in[15];
    const float* lk2 = (const float*)d_in[16]; const float* g_da = (const float*)d_in[17]; const float* g_rt = (const float*)d_in[18]; const float* w_bd = (const float*)d_in[19];
    const float* w_br = (const float*)d_in[20]; const float* w_o = (const float*)d_in[21]; const float* g_ffn = (const float*)d_in[22]; const float* w_g = (const float*)d_in[23];
    const float* w_u = (const float*)d_in[24]; const float* conv_w = (const float*)d_in[25]; const float* conv_b = (const float*)d_in[26]; const float* w_d = (const float*)d_in[27];
    const float* g_pe = (const float*)d_in[28]; const float* w_pe = (const float*)d_in[29]; const float* w_pg = (const float*)d_in[30];
    float* out = (float*)d_out;
    float* y = out; float* k_p = out + (size_t)M * D; float* v_p = k_p + (size_t)MP * 512; float* r_p = v_p + (size_t)MP * 512; float* c_p = r_p + (size_t)16 * 4 * 128 * 128;
    float* k_s = c_p + (size_t)16 * 2 * DFF; float* v_s = k_s + (size_t)MS * 512; float* r_s = v_s + (size_t)MS * 512; float* c_s = r_s + (size_t)32 * 4 * 128 * 128;
    (void)k_p; (void)k_s; (void)v_p; (void)v_s;
    static int grid = 0;
    if (grid == 0) {
        if (ws_size < WS_END) { fprintf(stderr, "kernel_launch: workspace too small: need %zu have %zu\n", (size_t)WS_END, ws_size); grid = -1; return; }
        int dev = 0, cus = 0; hipGetDevice(&dev); hipDeviceGetAttribute(&cus, hipDeviceAttributeMultiprocessorCount, dev);
        if (hipFuncSetAttribute((const void*)mk_fwd, hipFuncAttributeMaxDynamicSharedMemorySize, LDS_BYTES) != hipSuccess) { fprintf(stderr, "kernel_launch: hipFuncSetAttribute failed\n"); grid = -1; return; }
        grid = cus;
    }
    if (grid < 0) return;
    unsigned char* ws = (unsigned char*)d_ws;
    hipMemsetAsync(ws + WS_CTL, 0, CTL_ZERO_BYTES, stream);
    Args a; memset(&a, 0, sizeof(a));
    for (int i = 0; i < 31; ++i) a.in[i] = (const float*)d_in[i];
    a.out = out; a.ws = ws;
    a.li = 0; a.ph_lo = 0; a.ph_hi = 9; hipLaunchKernelGGL(mk_fwd, dim3(grid), dim3(NWAVES * 64), LDS_BYTES, stream, a);
}
```
